# Optimizing an MI355X kernel written in HIP

```python
import math
import jax, jax.numpy as jnp
from jax import lax
import numpy as np

D_MODEL = 1024
BATCH = 4
SEQ = 8192
DEPTH = 1

HEAD_DIM = 64
RWKV_HEADS = 8
RWKV_WIDTH = RWKV_HEADS * HEAD_DIM
ATT_HEADS = 8
ATT_WIDTH = ATT_HEADS * HEAD_DIM
IDX_HEADS = 8
IDX_DIM = 64
DECAY_RANK = 64
AAA_RANK = 64
GATE_RANK = 128
MAX_TOPK = 256
Q_BLOCK = 128
ROPE_THETA = 10000.0
D_FF = ((8 * D_MODEL // 3 + 255) // 256) * 256
NORM_EPS = 1e-6
LNX_EPS = 64e-5

RWKV_COLS = 3 * RWKV_WIDTH + DECAY_RANK + AAA_RANK + GATE_RANK
ATT_COLS = 3 * ATT_WIDTH
IDX_COLS = IDX_HEADS * IDX_DIM + IDX_DIM + IDX_HEADS
GATE_COLS = 2 * D_MODEL
IN_COLS = RWKV_COLS + ATT_COLS + IDX_COLS + GATE_COLS

kernel_name = "hybrid_rwkv7_dsa_gated_block"


def rmsnorm(x, g):
    xf = x.astype(jnp.float32)
    y = xf * lax.rsqrt(jnp.mean(xf * xf, axis=-1, keepdims=True) + NORM_EPS)
    return (y * g.astype(jnp.float32)).astype(x.dtype)


def rope(t):
    S, D = t.shape[1], t.shape[-1]
    half = D // 2
    inv = 1.0 / (ROPE_THETA ** (jnp.arange(half, dtype=jnp.float32) * 2.0 / D))
    ang = jnp.arange(S, dtype=jnp.float32)[:, None] * inv[None, :]
    cos = jnp.cos(ang)[None, :, None, :]
    sin = jnp.sin(ang)[None, :, None, :]
    tf = t.astype(jnp.float32)
    t1, t2 = tf[..., :half], tf[..., half:]
    return jnp.concatenate([t1 * cos - t2 * sin, t1 * sin + t2 * cos], axis=-1).astype(t.dtype)


def token_shift(p, mu):
    prev = jnp.pad(p, ((0, 0), (1, 0), (0, 0)))[:, :-1]
    return p + (prev - p) * mu


def rwkv7_mix(p, w_decay_up, w0, a_up, a0, g_up, k_k, k_a, r_k, lnx_g, lnx_b):
    B, S, _ = p.shape
    H, N = RWKV_HEADS, HEAD_DIM
    c = np.cumsum([RWKV_WIDTH, RWKV_WIDTH, RWKV_WIDTH, DECAY_RANK, AAA_RANK])
    r, k, v, wd, ad, gd = jnp.split(p, c, axis=-1)
    w = -jax.nn.softplus(-(w0 + jnp.tanh(wd) @ w_decay_up)) - 0.5
    a = jax.nn.sigmoid(a0 + ad @ a_up)
    g = jax.nn.sigmoid(gd) @ g_up
    kk = (k * k_k).reshape(B, S, H, N).astype(jnp.float32)
    kk = kk / jnp.maximum(jnp.linalg.norm(kk, axis=-1, keepdims=True), 1e-12)
    k = k * (1.0 + (a - 1.0) * k_a)
    heads = lambda t: t.reshape(B, S, H, N).astype(jnp.float32)
    r_h, k_h, v_h, a_h = heads(r), heads(k), heads(v), heads(a)
    decay = jnp.exp(-jnp.exp(heads(w)))
    tm = lambda t: jnp.moveaxis(t, 1, 0)

    def step(state, inp):
        r_t, d_t, k_t, v_t, kk_t, a_t = inp
        sa = jnp.einsum('bhij,bhj->bhi', state, -kk_t)
        state = (state * d_t[:, :, None, :]
                 + sa[..., None] * (kk_t * a_t)[:, :, None, :]
                 + v_t[..., None] * k_t[:, :, None, :])
        y_t = jnp.einsum('bhij,bhj->bhi', state, r_t)
        return state, y_t

    state0 = jnp.zeros((B, H, N, N), jnp.float32)
    _, y = lax.scan(step, state0, (tm(r_h), tm(decay), tm(k_h), tm(v_h), tm(kk), tm(a_h)))
    y = jnp.moveaxis(y, 0, 1)
    mean = jnp.mean(y, axis=-1, keepdims=True)
    var = jnp.mean(jnp.square(y - mean), axis=-1, keepdims=True)
    y = (y - mean) * lax.rsqrt(var + LNX_EPS)
    y = y * lnx_g.reshape(H, N) + lnx_b.reshape(H, N)
    bonus = jnp.sum(r_h * k_h * r_k.astype(jnp.float32), axis=-1, keepdims=True) * v_h
    y = (y + bonus).reshape(B, S, RWKV_WIDTH).astype(p.dtype)
    return y * g


def dsa_attention(q, k, v, q_idx, k_idx, w_idx):
    B, S, H, Dh = q.shape
    topk = min(MAX_TOPK, S // 4)
    nb = S // Q_BLOCK
    blk = lambda t: jnp.moveaxis(t.reshape((B, nb, Q_BLOCK) + t.shape[2:]), 1, 0)
    key_pos = jnp.arange(S)
    idx_scale = IDX_DIM ** -0.5 * IDX_HEADS ** -0.5

    def one_block(args):
        qb, qib, wib, bi = args
        t = bi * Q_BLOCK + jnp.arange(Q_BLOCK)
        sc = jax.nn.relu(jnp.einsum('bqhd,bsd->bqhs', qib, k_idx).astype(jnp.float32))
        score = jnp.einsum('bqhs,bqh->bqs', sc, wib.astype(jnp.float32)) * idx_scale
        causal = key_pos[None, None, :] <= t[None, :, None]
        score = jnp.where(causal, score, -jnp.inf)
        _, sel = lax.top_k(score, topk)
        valid = sel <= t[None, :, None]
        kg = jax.vmap(lambda kb, ib: kb[ib])(k, sel)
        vg = jax.vmap(lambda vb, ib: vb[ib])(v, sel)
        logits = jnp.einsum('bqhd,bqkhd->bqhk', qb, kg).astype(jnp.float32) * Dh ** -0.5
        logits = jnp.where(valid[:, :, None, :], logits, -jnp.inf)
        prob = jax.nn.softmax(logits, axis=-1).astype(vg.dtype)
        return jnp.einsum('bqhk,bqkhd->bqhd', prob, vg)

    out = lax.map(one_block, (blk(q), blk(q_idx), blk(w_idx), jnp.arange(nb)))
    return jnp.moveaxis(out, 0, 1).reshape(B, S, H * Dh)


def setup_inputs(seed: int = 0) -> dict:
    key = jax.random.key(seed)
    ks = jax.random.split(key, 24)
    nrm = lambda k, shape, s: jax.random.normal(k, shape, jnp.float32) * s
    return {
        "x": jax.random.normal(ks[0], (BATCH, SEQ, D_MODEL), jnp.float32),
        "norm1_g": 1.0 + nrm(ks[1], (D_MODEL,), 0.05),
        "w_in": nrm(ks[2], (D_MODEL, IN_COLS), D_MODEL ** -0.5),
        "tshift_mu": jax.random.uniform(ks[3], (RWKV_COLS,), jnp.float32),
        "w_decay_up": nrm(ks[4], (DECAY_RANK, RWKV_WIDTH), 0.5 * DECAY_RANK ** -0.5),
        "w0": nrm(ks[5], (RWKV_WIDTH,), 0.5),
        "a_up": nrm(ks[6], (AAA_RANK, RWKV_WIDTH), 0.5 * AAA_RANK ** -0.5),
        "a0": nrm(ks[7], (RWKV_WIDTH,), 0.5),
        "g_up": nrm(ks[8], (GATE_RANK, RWKV_WIDTH), GATE_RANK ** -0.5),
        "k_k": 0.85 + nrm(ks[9], (RWKV_WIDTH,), 0.05),
        "k_a": 1.0 + nrm(ks[10], (RWKV_WIDTH,), 0.05),
        "r_k": nrm(ks[11], (RWKV_HEADS, HEAD_DIM), 0.1),
        "lnx_g": 1.0 + nrm(ks[12], (RWKV_WIDTH,), 0.05),
        "lnx_b": nrm(ks[13], (RWKV_WIDTH,), 0.01),
        "w_o_rwkv": nrm(ks[14], (RWKV_WIDTH, D_MODEL), RWKV_WIDTH ** -0.5),
        "w_o_att": nrm(ks[15], (ATT_WIDTH, D_MODEL), ATT_WIDTH ** -0.5),
        "w_out": nrm(ks[16], (D_MODEL, D_MODEL), D_MODEL ** -0.5),
        "norm2_g": 1.0 + nrm(ks[17], (D_MODEL,), 0.05),
        "w_ffn_in": nrm(ks[18], (D_MODEL, 2 * D_FF), D_MODEL ** -0.5),
        "w_ffn_out": nrm(ks[19], (D_FF, D_MODEL), D_FF ** -0.5),
        "normf_g": 1.0 + nrm(ks[20], (D_MODEL,), 0.05),
    }


def reference(x, norm1_g, w_in, tshift_mu, w_decay_up, w0, a_up, a0, g_up, k_k, k_a, r_k,
              lnx_g, lnx_b, w_o_rwkv, w_o_att, w_out, norm2_g, w_ffn_in, w_ffn_out, normf_g):
    B, S, _ = x.shape
    h = x
    for _layer in range(DEPTH):
        u = rmsnorm(h, norm1_g)
        proj = u @ w_in
        c = np.cumsum([RWKV_COLS, ATT_COLS, IDX_COLS])
        p_rwkv, p_att, p_idx, p_gate = jnp.split(proj, c, axis=-1)

        y_a = rwkv7_mix(token_shift(p_rwkv, tshift_mu), w_decay_up, w0, a_up, a0, g_up,
                        k_k, k_a, r_k, lnx_g, lnx_b)

        q, k, v = jnp.split(p_att, 3, axis=-1)
        hv = lambda t: t.reshape(B, S, ATT_HEADS, HEAD_DIM)
        q, k, v = rope(hv(q)), rope(hv(k)), hv(v)
        ci = np.cumsum([IDX_HEADS * IDX_DIM, IDX_DIM])
        q_idx, k_idx, w_idx = jnp.split(p_idx, ci, axis=-1)
        q_idx = rope(q_idx.reshape(B, S, IDX_HEADS, IDX_DIM))
        k_idx = rope(k_idx[:, :, None, :])[:, :, 0, :]
        y_b = dsa_attention(q, k, v, q_idx, k_idx, w_idx)

        g_a, g_b = jnp.split(jax.nn.sigmoid(p_gate), 2, axis=-1)
        merged = g_a * (y_a @ w_o_rwkv) + g_b * (y_b @ w_o_att)
        h = h + merged @ w_out

        z = rmsnorm(h, norm2_g) @ w_ffn_in
        z_gate, z_up = jnp.split(z, 2, axis=-1)
        h = h + (jax.nn.silu(z_gate) * z_up) @ w_ffn_out
    return rmsnorm(h, normf_g)
```

```cpp
#include <hip/hip_runtime.h>
#include <hip/hip_cooperative_groups.h>
#include <cstdio>
#include <cmath>
#include <cstring>
namespace cg = cooperative_groups;

typedef _Float16 half_t;
typedef _Float16 h8 __attribute__((ext_vector_type(8)));
typedef _Float16 h4 __attribute__((ext_vector_type(4)));
typedef _Float16 h2 __attribute__((ext_vector_type(2)));
typedef float f16v __attribute__((ext_vector_type(16)));
typedef float f4 __attribute__((ext_vector_type(4)));
typedef unsigned short u16;
typedef unsigned u32x4 __attribute__((ext_vector_type(4)));
typedef int i32x4 __attribute__((ext_vector_type(4)));

#define NTOK 32768
#define SEQ 8192
#define NTHREADS 512
#ifndef PROBE_DUP
#define PROBE_DUP -1
#endif
#ifndef LORA_PARTS
#define LORA_PARTS 7
#endif
#define LDS_BYTES 151552

constexpr size_t OFF_WIN  = 0;
constexpr size_t OFF_WG   = OFF_WIN  + 8388608;
constexpr size_t OFF_WD   = OFF_WG   + 4194304;
constexpr size_t OFF_AUP  = OFF_WD   + 65536;
constexpr size_t OFF_GUP  = OFF_AUP  + 65536;
constexpr size_t OFF_WOR  = OFF_GUP  + 131072;
constexpr size_t OFF_WOA  = OFF_WOR  + 1048576;
constexpr size_t OFF_WOUT = OFF_WOA  + 1048576;
constexpr size_t OFF_WF1  = OFF_WOUT + 2097152;
constexpr size_t OFF_WF2  = OFF_WF1  + 11534336;
constexpr size_t OFF_ROPE = OFF_WF2  + 5767168;
constexpr size_t OFF_U16  = OFF_ROPE + 2097152;
constexpr size_t OFF_Q    = OFF_U16  + 67108864;
constexpr size_t OFF_KH   = OFF_Q    + 33554432;
constexpr size_t OFF_VH   = OFF_KH   + 33554432;
constexpr size_t OFF_QI   = OFF_VH   + 33554432;
constexpr size_t OFF_KI   = OFF_QI   + 33554432;
constexpr size_t OFF_WI   = OFF_KI   + 4194304;
constexpr size_t OFF_PR   = OFF_WI   + 1048576;
constexpr size_t OFF_YRAW = OFF_PR;
constexpr size_t OFF_YB   = OFF_PR + 67108864;
constexpr size_t OFF_SEL  = OFF_YB + 33554432;
constexpr size_t OFF_LA   = OFF_PR   + 117440512;
constexpr size_t OFF_D    = OFF_LA   + 16777216;
constexpr size_t OFF_VS   = OFF_D    + 67108864;
constexpr size_t OFF_G    = OFF_VS   + 33554432;
constexpr size_t OFF_RK   = OFF_G    + 33554432;
constexpr size_t WS_END   = OFF_RK   + 1048576;

struct Params {
    const float* in[21];
    float* out;
    unsigned char* ws;
    double invf[32];
};
enum { I_X = 0, I_N1G, I_WIN, I_MU, I_WDU, I_W0, I_AUP, I_A0, I_GUP, I_KK, I_KA, I_RK, I_LNG, I_LNB, I_WOR, I_WOA, I_WOUT, I_N2G, I_WF1, I_WF2, I_NFG };

__device__ __forceinline__ float sigm(float x) { return 1.0f / (1.0f + __expf(-x)); }

template <int CTRL> __device__ __forceinline__ float dppf(float x) {
    return __int_as_float(__builtin_amdgcn_update_dpp(0, __float_as_int(x), CTRL, 0xf, 0xf, false));
}
__device__ __forceinline__ float rowsum16(float x) {
    x += dppf<0x128>(x); x += dppf<0x124>(x); x += dppf<0x122>(x); x += dppf<0x121>(x); return x;
}
__device__ __forceinline__ float sum8(float x) {
    x += dppf<0xB1>(x); x += dppf<0x4E>(x); x += dppf<0x141>(x); return x;
}
__device__ __forceinline__ float wave_sum(float x) {
#pragma unroll
    for (int o = 32; o >= 1; o >>= 1) x += __shfl_xor(x, o);
    return x;
}
__device__ __forceinline__ float wave_max(float x) {
#pragma unroll
    for (int o = 32; o >= 1; o >>= 1) x = fmaxf(x, __shfl_xor(x, o));
    return x;
}

__device__ __forceinline__ int colmap(int mode, int n) {
    if (mode == 1) return n < 3912 ? n : -1;
    if (mode == 2) return 3912 + n;
    if (mode == 3) { const int g = n >> 6, r = n & 63; return r < 32 ? g * 32 + r : 2816 + g * 32 + (r - 32); }
    return n;
}
__device__ __forceinline__ void conv_tile(const float* __restrict__ src, int ldsrc, int K, int mode, half_t* __restrict__ dst, int kt, int nt, float* tile) {
    const int tid = threadIdx.x;
    const int nn = tid & 63, kk = tid >> 6;
    const int col = colmap(mode, nt * 64 + nn);
#pragma unroll
    for (int i = 0; i < 8; ++i) {
        const int k = kk + 8 * i;
        tile[k * 65 + nn] = col >= 0 ? src[(size_t)(kt * 64 + k) * ldsrc + col] : 0.f;
    }
    __syncthreads();
#pragma unroll
    for (int i = 0; i < 8; ++i) {
        const int n = kk + 8 * i;
        dst[(size_t)(nt * 64 + n) * K + kt * 64 + nn] = (half_t)tile[nn * 65 + n];
    }
    __syncthreads();
}

__device__ __forceinline__ void sincos_d(double a, float& c, float& s) {
    const double n = rint(a * 0.63661977236758134308);
    double r = fma(-n, 1.57079632679489655800e+00, a);
    r = fma(-n, 6.12323399573676603587e-17, r);
    const double r2 = r * r;
    double sp = -1.0 / 1307674368000.0;
    sp = fma(sp, r2, 1.0 / 6227020800.0);
    sp = fma(sp, r2, -1.0 / 39916800.0);
    sp = fma(sp, r2, 1.0 / 362880.0);
    sp = fma(sp, r2, -1.0 / 5040.0);
    sp = fma(sp, r2, 1.0 / 120.0);
    sp = fma(sp, r2, -1.0 / 6.0);
    const double sn = fma(sp * r2, r, r);
    double cp = 1.0 / 20922789888000.0;
    cp = fma(cp, r2, -1.0 / 87178291200.0);
    cp = fma(cp, r2, 1.0 / 479001600.0);
    cp = fma(cp, r2, -1.0 / 3628800.0);
    cp = fma(cp, r2, 1.0 / 40320.0);
    cp = fma(cp, r2, -1.0 / 720.0);
    cp = fma(cp, r2, 1.0 / 24.0);
    cp = fma(cp, r2, -0.5);
    const double cs = fma(cp, r2, 1.0);
    const int q = ((int)n) & 3;
    double cc = (q & 1) ? sn : cs, ss = (q & 1) ? cs : sn;
    if (q == 1 || q == 2) cc = -cc;
    if (q == 2 || q == 3) ss = -ss;
    c = (float)cc; s = (float)ss;
}

__device__ __forceinline__ void rmsnorm_rows_f16(const float* __restrict__ x, const float* __restrict__ g, half_t* __restrict__ o) {
    const int lane = threadIdx.x & 63, wid = threadIdx.x >> 6;
    for (int row = blockIdx.x * 8 + wid; row < NTOK; row += gridDim.x * 8) {
        const f4* xr = (const f4*)(x + (size_t)row * 1024);
        f4 v[4]; float ss = 0.f;
#pragma unroll
        for (int i = 0; i < 4; ++i) { v[i] = xr[lane + 64 * i]; ss += v[i][0] * v[i][0] + v[i][1] * v[i][1] + v[i][2] * v[i][2] + v[i][3] * v[i][3]; }
        ss = wave_sum(ss);
        const float rs = rsqrtf(ss * (1.0f / 1024.0f) + 1e-6f);
#pragma unroll
        for (int i = 0; i < 4; ++i) {
            const f4 gg = ((const f4*)g)[lane + 64 * i];
            h4 w; w[0] = (half_t)(v[i][0] * rs * gg[0]); w[1] = (half_t)(v[i][1] * rs * gg[1]); w[2] = (half_t)(v[i][2] * rs * gg[2]); w[3] = (half_t)(v[i][3] * rs * gg[3]);
            *(h4*)(o + (size_t)row * 1024 + (lane + 64 * i) * 4) = w;
        }
    }
}

__device__ __forceinline__ void phase_convert(const Params& p, unsigned char* lds) {
    float* tile = (float*)lds;
    unsigned char* ws = p.ws;
    const int total = 1024 + 512 + 8 + 8 + 16 + 128 + 128 + 256 + 1408 + 704;
    for (int t = blockIdx.x; t < total; t += gridDim.x) {
        int j, r;
        if (t < 1024) { j = 0; r = t; } else if (t < 1536) { j = 1; r = t - 1024; } else if (t < 1544) { j = 2; r = t - 1536; } else if (t < 1552) { j = 3; r = t - 1544; }
        else if (t < 1568) { j = 4; r = t - 1552; } else if (t < 1696) { j = 5; r = t - 1568; } else if (t < 1824) { j = 6; r = t - 1696; } else if (t < 2080) { j = 7; r = t - 1824; }
        else if (t < 3488) { j = 8; r = t - 2080; } else { j = 9; r = t - 3488; }
        if (j == 0) conv_tile(p.in[I_WIN], 5960, 1024, 1, (half_t*)(ws + OFF_WIN), r / 64, r % 64, tile);
        else if (j == 1) conv_tile(p.in[I_WIN], 5960, 1024, 2, (half_t*)(ws + OFF_WG), r / 32, r % 32, tile);
        else if (j == 2) conv_tile(p.in[I_WDU], 512, 64, 0, (half_t*)(ws + OFF_WD), r / 8, r % 8, tile);
        else if (j == 3) conv_tile(p.in[I_AUP], 512, 64, 0, (half_t*)(ws + OFF_AUP), r / 8, r % 8, tile);
        else if (j == 4) conv_tile(p.in[I_GUP], 512, 128, 0, (half_t*)(ws + OFF_GUP), r / 8, r % 8, tile);
        else if (j == 5) conv_tile(p.in[I_WOR], 1024, 512, 0, (half_t*)(ws + OFF_WOR), r / 16, r % 16, tile);
        else if (j == 6) conv_tile(p.in[I_WOA], 1024, 512, 0, (half_t*)(ws + OFF_WOA), r / 16, r % 16, tile);
        else if (j == 7) conv_tile(p.in[I_WOUT], 1024, 1024, 0, (half_t*)(ws + OFF_WOUT), r / 16, r % 16, tile);
        else if (j == 8) conv_tile(p.in[I_WF1], 5632, 1024, 3, (half_t*)(ws + OFF_WF1), r / 88, r % 88, tile);
        else conv_tile(p.in[I_WF2], 1024, 2816, 0, (half_t*)(ws + OFF_WF2), r / 16, r % 16, tile);
    }
    float2* rope = (float2*)(ws + OFF_ROPE);
    for (int i = blockIdx.x * NTHREADS + threadIdx.x; i < SEQ * 32; i += gridDim.x * NTHREADS) {
        const int pos = i >> 5, j = i & 31;
        float c, s; sincos_d((double)pos * p.invf[j], c, s);
        rope[i] = make_float2(c, s);
    }
    rmsnorm_rows_f16(p.in[I_X], p.in[I_N1G], (half_t*)(ws + OFF_U16));
}

__device__ __forceinline__ u32x4 gload_asm(const void* p) {
    u32x4 r;
    asm volatile("global_load_dwordx4 %0, %1, off" : "=&v"(r) : "v"(p) : "memory");
    return r;
}
__device__ __forceinline__ u32x4 gload_asm_s(const void* sbase, unsigned voff) {
    u32x4 r;
    asm volatile("global_load_dwordx4 %0, %1, %2" : "=&v"(r) : "v"(voff), "s"(sbase) : "memory");
    return r;
}
template <int NJ>
__device__ __forceinline__ void gemm_main(f16v (&acc)[2][NJ], const half_t* __restrict__ A, int lda, const half_t* __restrict__ Bt, int ldb, int K, int m0, int n0, unsigned char* lds) {
    const int tid = threadIdx.x, lane = tid & 63, wid = tid >> 6, wm = wid >> 1, wn = wid & 1;
    constexpr int NB = NJ;
    constexpr int STAGE = 32768 + 64 * NJ * 128;
#pragma unroll
    for (int mi = 0; mi < 2; ++mi)
#pragma unroll
        for (int nj = 0; nj < NJ; ++nj)
#pragma unroll
            for (int e = 0; e < 16; ++e) acc[mi][nj][e] = 0.f;
    const int srow = tid >> 3, sch = tid & 7;
    const int swz_w = (sch ^ ((srow >> 1) & 7)) << 4;
    const half_t* Ag = A + (size_t)(m0 + srow) * lda + sch * 8;
    const half_t* Bg = Bt + (size_t)(n0 + srow) * ldb + sch * 8;
    u32x4 ra[4], rb[NB];
    const int nk = K >> 6;
#pragma unroll
    for (int i = 0; i < 4; ++i) ra[i] = *(const u32x4*)(Ag + (size_t)i * 64 * lda);
#pragma unroll
    for (int i = 0; i < NB; ++i) rb[i] = *(const u32x4*)(Bg + (size_t)i * 64 * ldb);
    __syncthreads();
#pragma unroll
    for (int i = 0; i < 4; ++i) *(u32x4*)(lds + (srow + 64 * i) * 128 + swz_w) = ra[i];
#pragma unroll
    for (int i = 0; i < NB; ++i) *(u32x4*)(lds + 32768 + (srow + 64 * i) * 128 + swz_w) = rb[i];
    {
        const int k0 = (nk > 1 ? 1 : 0) * 64;
#pragma unroll
        for (int i = 0; i < 4; ++i) ra[i] = *(const u32x4*)(Ag + (size_t)i * 64 * lda + k0);
#pragma unroll
        for (int i = 0; i < NB; ++i) rb[i] = *(const u32x4*)(Bg + (size_t)i * 64 * ldb + k0);
    }
    const int r31 = lane & 31, hh = lane >> 5;
    const int swz_r = (r31 >> 1) & 7;
    for (int kt = 0; kt < nk; ++kt) {
        __syncthreads();
        {
            unsigned char* nb = lds + ((kt + 1) & 1) * STAGE;
#pragma unroll
            for (int i = 0; i < 4; ++i) *(u32x4*)(nb + (srow + 64 * i) * 128 + swz_w) = ra[i];
#pragma unroll
            for (int i = 0; i < NB; ++i) *(u32x4*)(nb + 32768 + (srow + 64 * i) * 128 + swz_w) = rb[i];
            const int k0 = (kt + 2 < nk ? kt + 2 : nk - 1) * 64;
#pragma unroll
            for (int i = 0; i < 4; ++i) ra[i] = *(const u32x4*)(Ag + (size_t)i * 64 * lda + k0);
#pragma unroll
            for (int i = 0; i < NB; ++i) rb[i] = *(const u32x4*)(Bg + (size_t)i * 64 * ldb + k0);
            __builtin_amdgcn_sched_barrier(0);
        }
        const unsigned char* base = lds + (kt & 1) * STAGE;
        const unsigned char* aB = base + (wm * 64 + r31) * 128;
        const unsigned char* bB = base + 32768 + (wn * 32 * NJ + r31) * 128;
#pragma unroll
        for (int ks = 0; ks < 4; ++ks) {
            const int co = ((ks * 2 + hh) ^ swz_r) << 4;
            h8 af[2], bf[NJ];
#pragma unroll
            for (int mi = 0; mi < 2; ++mi) af[mi] = *(const h8*)(aB + mi * 32 * 128 + co);
#pragma unroll
            for (int nj = 0; nj < NJ; ++nj) bf[nj] = *(const h8*)(bB + nj * 32 * 128 + co);
#pragma unroll
            for (int mi = 0; mi < 2; ++mi)
#pragma unroll
                for (int nj = 0; nj < NJ; ++nj) acc[mi][nj] = __builtin_amdgcn_mfma_f32_32x32x16_f16(bf[nj], af[mi], acc[mi][nj], 0, 0, 0);
        }
    }
    asm volatile("s_waitcnt vmcnt(0)" ::: "memory");
}

#define XCD_TILE_LOOP(NTn) for (int L_ = (int)blockIdx.x >> 3; L_ < 16 * (NTn); L_ += (int)gridDim.x >> 3)
__device__ __forceinline__ void xcd_tile(int L, int NTn, int& mt, int& nt) {
    const int nfull = NTn >> 2, x16 = ((int)blockIdx.x & 7) * 16;
    if (L < nfull * 64) { const int q = L >> 6, r = L & 63; nt = q * 4 + ((r & 31) >> 3); mt = x16 + (r >> 5) * 8 + (r & 7); }
    else { const int r = L - nfull * 64; nt = nfull * 4 + (r >> 4); mt = x16 + (r & 15); }
}
__device__ __forceinline__ h4 pack4(float a, float b, float c, float d) { h4 w; w[0] = (half_t)a; w[1] = (half_t)b; w[2] = (half_t)c; w[3] = (half_t)d; return w; }

__device__ __forceinline__ void epi_inproj(const Params& p, f16v (&acc)[2][4], int m0, int n0) {
    const int tid = threadIdx.x, lane = tid & 63, wid = tid >> 6, wm = wid >> 1, wn = wid & 1, r31 = lane & 31, hh = lane >> 5;
    const int nb = n0 + wn * 128;
    if (nb >= 3968) return;
    unsigned char* ws = p.ws;
    const float2* rope = (const float2*)(ws + OFF_ROPE);
#pragma unroll
    for (int mi = 0; mi < 2; ++mi) {
        const int m = m0 + wm * 64 + mi * 32 + r31, pos = m & (SEQ - 1), b = m >> 13;
        if (nb < 1792) {
            half_t* dst = (half_t*)(ws + OFF_PR) + (size_t)m * 1792 + nb + hh * 4;
#pragma unroll
            for (int nj = 0; nj < 4; ++nj)
#pragma unroll
                for (int rg = 0; rg < 4; ++rg)
                    *(h4*)(dst + nj * 32 + rg * 8) = pack4(acc[mi][nj][rg * 4], acc[mi][nj][rg * 4 + 1], acc[mi][nj][rg * 4 + 2], acc[mi][nj][rg * 4 + 3]);
        } else {
#pragma unroll
            for (int hd = 0; hd < 2; ++hd) {
                const int nh = nb + hd * 64;
                half_t* dst; bool dorope = true; float sc = 1.0f;
                if (nh < 2304) { dst = (half_t*)(ws + OFF_Q) + (size_t)m * 512 + (nh - 1792); sc = 0.125f; }
                else if (nh < 2816) { dst = (half_t*)(ws + OFF_KH) + ((size_t)(b * 8 + ((nh - 2304) >> 6)) * SEQ + pos) * 64; }
                else if (nh < 3328) { dst = (half_t*)(ws + OFF_VH) + ((size_t)(b * 8 + ((nh - 2816) >> 6)) * SEQ + pos) * 64; dorope = false; }
                else if (nh < 3840) { dst = (half_t*)(ws + OFF_QI) + (size_t)m * 512 + (nh - 3328); }
                else if (nh == 3840) { dst = (half_t*)(ws + OFF_KI) + (size_t)m * 64; }
                else {
                    if (hd == 1) {
                        f4 w;
                        w[0] = acc[mi][2][0] * 0.044194173824159216f; w[1] = acc[mi][2][1] * 0.044194173824159216f;
                        w[2] = acc[mi][2][2] * 0.044194173824159216f; w[3] = acc[mi][2][3] * 0.044194173824159216f;
                        *(f4*)((float*)(ws + OFF_WI) + (size_t)m * 8 + hh * 4) = w;
                    }
                    continue;
                }
#pragma unroll
                for (int rg = 0; rg < 4; ++rg) {
                    const int d = rg * 8 + hh * 4;
                    float o1[4], o2[4];
                    if (dorope) {
                        const f4 cs0 = *(const f4*)(rope + pos * 32 + d), cs1 = *(const f4*)(rope + pos * 32 + d + 2);
                        const float c[4] = {cs0[0], cs0[2], cs1[0], cs1[2]}, s[4] = {cs0[1], cs0[3], cs1[1], cs1[3]};
#pragma unroll
                        for (int e = 0; e < 4; ++e) {
                            const float x1 = acc[mi][2 * hd][rg * 4 + e], x2 = acc[mi][2 * hd + 1][rg * 4 + e];
                            o1[e] = (x1 * c[e] - x2 * s[e]) * sc; o2[e] = (x1 * s[e] + x2 * c[e]) * sc;
                        }
                    } else {
#pragma unroll
                        for (int e = 0; e < 4; ++e) { o1[e] = acc[mi][2 * hd][rg * 4 + e]; o2[e] = acc[mi][2 * hd + 1][rg * 4 + e]; }
                    }
                    *(h4*)(dst + d) = pack4(o1[0], o1[1], o1[2], o1[3]);
                    *(h4*)(dst + d + 32) = pack4(o2[0], o2[1], o2[2], o2[3]);
                }
            }
        }
    }
}

__device__ __forceinline__ void phase_inproj(const Params& p, unsigned char* lds) {
    const half_t* A = (const half_t*)(p.ws + OFF_U16);
    const half_t* Bt = (const half_t*)(p.ws + OFF_WIN);
    XCD_TILE_LOOP(16) {
        int mt, nt; xcd_tile(L_, 16, mt, nt);
        f16v acc[2][4];
        gemm_main<4>(acc, A, 1024, Bt, 1024, 1024, mt * 256, nt * 256, lds);
        epi_inproj(p, acc, mt * 256, nt * 256);
    }
}

__device__ __forceinline__ void phase_prep(const Params& p) {
    const half_t* PR = (const half_t*)(p.ws + OFF_PR);
    half_t* LA = (half_t*)(p.ws + OFF_LA);
    const float* mu = p.in[I_MU];
    for (int i = blockIdx.x * NTHREADS + threadIdx.x; i < NTOK * 32; i += gridDim.x * NTHREADS) {
        const int m = i >> 5, c8 = (i & 31) * 8, pos = m & (SEQ - 1);
        const h8 cur = *(const h8*)(PR + (size_t)m * 1792 + 1536 + c8);
        h8 prv;
        if (pos > 0) prv = *(const h8*)(PR + (size_t)(m - 1) * 1792 + 1536 + c8);
        else {
#pragma unroll
            for (int e = 0; e < 8; ++e) prv[e] = (half_t)0.f;
        }
        h8 o;
#pragma unroll
        for (int e = 0; e < 8; ++e) {
            const float x = (float)cur[e], xp = (float)prv[e];
            const float s = x + (xp - x) * mu[1536 + c8 + e];
            float r;
            if (c8 < 64) r = tanhf(s); else if (c8 < 128) r = s; else r = sigm(s);
            o[e] = (half_t)r;
        }
        *(h8*)(LA + (size_t)m * 256 + c8) = o;
    }
}

__device__ __forceinline__ void ld_shift4(const half_t* cur, const half_t* prv, bool hasprev, const float* mu, float (&o)[4]) {
    const h4 a = *(const h4*)cur;
    h4 b;
    if (hasprev) b = *(const h4*)prv; else { b[0] = (half_t)0.f; b[1] = (half_t)0.f; b[2] = (half_t)0.f; b[3] = (half_t)0.f; }
    const f4 m4 = *(const f4*)mu;
#pragma unroll
    for (int e = 0; e < 4; ++e) { const float x = (float)a[e], xp = (float)b[e]; o[e] = x + (xp - x) * m4[e]; }
}

__device__ __forceinline__ void phase_lora(const Params& p, unsigned char* lds) {
    unsigned char* ws = p.ws;
    const half_t* LA = (const half_t*)(ws + OFF_LA);
    const half_t* PR = (const half_t*)(ws + OFF_PR);
    const int tid = threadIdx.x, lane = tid & 63, wid = tid >> 6, wm = wid >> 1, wn = wid & 1, r31 = lane & 31, hh = lane >> 5;
    if (LORA_PARTS & 1) for (int t = blockIdx.x; t < 128 * 2; t += gridDim.x) {
        const int mt = t >> 1, nt = t & 1, m0 = mt * 256, n0 = nt * 256, nb = n0 + wn * 128;
        f16v acc[2][4];
        gemm_main<4>(acc, LA, 256, (const half_t*)(ws + OFF_WD), 64, 64, m0, n0, lds);
        const float* w0 = p.in[I_W0];
#pragma unroll
        for (int mi = 0; mi < 2; ++mi) {
            const int m = m0 + wm * 64 + mi * 32 + r31, pos = m & (SEQ - 1), b = m >> 13;
#pragma unroll
            for (int nj = 0; nj < 4; ++nj)
#pragma unroll
                for (int rg = 0; rg < 4; ++rg) {
                    const int n = nb + nj * 32 + rg * 8 + hh * 4, h = n >> 6, j = n & 63;
                    const f4 w04 = *(const f4*)(w0 + n);
                    f4 dv;
#pragma unroll
                    for (int e = 0; e < 4; ++e) {
                        const float z = w04[e] + acc[mi][nj][rg * 4 + e];
                        dv[e] = __expf(-0.60653065971263342f / (1.0f + __expf(-z)));
                    }
                    *(f4*)((float*)(ws + OFF_D) + ((size_t)(b * 8 + h) * SEQ + pos) * 64 + j) = dv;
                }
        }
    }
    if (LORA_PARTS & 2) for (int t = blockIdx.x; t < 128 * 2; t += gridDim.x) {
        const int mt = t >> 1, nt = t & 1, m0 = mt * 256, n0 = nt * 256, nb = n0 + wn * 128;
        f16v acc[2][4];
        gemm_main<4>(acc, LA + 128, 256, (const half_t*)(ws + OFF_GUP), 128, 128, m0, n0, lds);
#pragma unroll
        for (int mi = 0; mi < 2; ++mi) {
            const int m = m0 + wm * 64 + mi * 32 + r31;
            half_t* G = (half_t*)(ws + OFF_G) + (size_t)m * 512 + nb + hh * 4;
#pragma unroll
            for (int nj = 0; nj < 4; ++nj)
#pragma unroll
                for (int rg = 0; rg < 4; ++rg)
                    *(h4*)(G + nj * 32 + rg * 8) = pack4(acc[mi][nj][rg * 4], acc[mi][nj][rg * 4 + 1], acc[mi][nj][rg * 4 + 2], acc[mi][nj][rg * 4 + 3]);
        }
    }
    if (LORA_PARTS & 4) for (int t = blockIdx.x; t < 128 * 4; t += gridDim.x) {
        const int mt = t >> 2, nt = t & 3, m0 = mt * 256, n0 = nt * 128;
        f16v acc[2][2];
        gemm_main<2>(acc, LA + 64, 256, (const half_t*)(ws + OFF_AUP), 64, 64, m0, n0, lds);
        const float* mu = p.in[I_MU]; const float* a0 = p.in[I_A0]; const float* kkw = p.in[I_KK]; const float* kaw = p.in[I_KA]; const float* rkw = p.in[I_RK];
        {
            const int h = (n0 >> 6) + wn;
#pragma unroll
            for (int mi = 0; mi < 2; ++mi) {
                const int m = m0 + wm * 64 + mi * 32 + r31, pos = m & (SEQ - 1), b = m >> 13;
                unsigned char* rec = (unsigned char*)p.out + ((size_t)(b * 8 + h) * SEQ + pos) * 512;
#pragma unroll
                for (int blk = 0; blk < 2; ++blk)
#pragma unroll
                    for (int rg = 0; rg < 4; ++rg) {
                        const int j = blk * 32 + rg * 8 + hh * 4, n = h * 64 + j;
                        const f4 a04 = *(const f4*)(a0 + n);
                        f4 av;
#pragma unroll
                        for (int e = 0; e < 4; ++e) av[e] = sigm(a04[e] + acc[mi][blk][rg * 4 + e]);
                        *(f4*)(rec + (j >> 2) * 32 + 16) = av;
                    }
            }
        }
        __threadfence_block();
        __syncthreads();
#pragma unroll 2
        for (int it = 0; it < 16; ++it) {
            const int idx = it * NTHREADS + tid, pair = idx >> 4, jg = idx & 15;
            const int m = m0 + (pair >> 1), h = (n0 >> 6) + (pair & 1), pos = m & (SEQ - 1), b = m >> 13, n = h * 64 + 4 * jg;
            const half_t* prow = PR + (size_t)m * 1792; const half_t* pprev = prow - 1792; const bool hp = pos > 0;
            float rs[4], ks[4], vs[4];
            ld_shift4(prow + n, pprev + n, hp, mu + n, rs);
            ld_shift4(prow + 512 + n, pprev + 512 + n, hp, mu + 512 + n, ks);
            ld_shift4(prow + 1024 + n, pprev + 1024 + n, hp, mu + 1024 + n, vs);
            unsigned char* rec = (unsigned char*)p.out + ((size_t)(b * 8 + h) * SEQ + pos) * 512 + jg * 32;
            const f4 av = *(const f4*)(rec + 16);
            const f4 kk4 = *(const f4*)(kkw + n), ka4 = *(const f4*)(kaw + n), rk4 = *(const f4*)(rkw + n);
            float kkr[4], kp[4], ss = 0.f, rka = 0.f;
#pragma unroll
            for (int e = 0; e < 4; ++e) {
                kkr[e] = ks[e] * kk4[e]; ss += kkr[e] * kkr[e];
                kp[e] = ks[e] * (1.0f + (av[e] - 1.0f) * ka4[e]);
                rka += rs[e] * kp[e] * rk4[e];
            }
            ss = rowsum16(ss); rka = rowsum16(rka);
            const float inv = 1.0f / fmaxf(sqrtf(ss), 1e-12f);
            h8 w0v, w1v;
#pragma unroll
            for (int e = 0; e < 4; ++e) {
                const float kk = kkr[e] * inv;
                w0v[e] = (half_t)rs[e]; w0v[4 + e] = (half_t)kp[e];
                w1v[e] = (half_t)kk; w1v[4 + e] = (half_t)(kk * av[e]);
            }
            *(h8*)rec = w0v;
            *(h8*)(rec + 16) = w1v;
            *(h4*)((half_t*)(ws + OFF_VS) + (size_t)m * 512 + n) = pack4(vs[0], vs[1], vs[2], vs[3]);
            if (jg == 0) ((float*)(ws + OFF_RK))[(size_t)m * 8 + h] = rka;
        }
    }
}

struct ScanIn { f4 d; u32x4 h0, h1; h2 v; };
__device__ __forceinline__ void phase_scan(const Params& p) {
    const int lane = threadIdx.x & 63, wid = threadIdx.x >> 6;
    const int jg = lane & 15, sub = lane >> 4;
    if (wid >= 4) return;
    {
        const int u = (int)blockIdx.x * 4 + wid;
        const int bh = u >> 3, rgp = u & 7, b = bh >> 3, h = bh & 7, i = rgp * 8 + sub * 2;
        const f4* Dp = (const f4*)(p.ws + OFF_D) + (size_t)bh * SEQ * 16 + jg;
        const u32x4* Hp = (const u32x4*)p.out + (size_t)bh * SEQ * 32 + jg * 2;
        const half_t* Vp = (const half_t*)(p.ws + OFF_VS) + (size_t)b * SEQ * 512 + h * 64 + i;
        float* Yp = (float*)(p.ws + OFF_YRAW) + (size_t)b * SEQ * 512 + h * 64 + i;
        float a0 = 0.f, a1 = 0.f, a2 = 0.f, a3 = 0.f, b0 = 0.f, b1 = 0.f, b2 = 0.f, b3 = 0.f;
        ScanIn A[4], Bf[4], C[4];
#define SCAN_LOAD(buf, tb) { _Pragma("unroll") for (int q = 0; q < 4; ++q) { int tt = (tb) + q; tt = tt < SEQ ? tt : SEQ - 1; \
            buf[q].d = Dp[(size_t)tt * 16]; buf[q].h0 = Hp[(size_t)tt * 32]; buf[q].h1 = Hp[(size_t)tt * 32 + 1]; buf[q].v = *(const h2*)(Vp + (size_t)tt * 512); } }
#define SCAN_STEP(buf, tb) { float ya[4], yb[4]; _Pragma("unroll") for (int q = 0; q < 4; ++q) { \
            const h8 x0 = *(const h8*)&buf[q].h0, x1 = *(const h8*)&buf[q].h1; const f4 d = buf[q].d; \
            const float va = (float)buf[q].v[0], vb = (float)buf[q].v[1]; \
            const float k0 = (float)x1[0], k1 = (float)x1[1], k2 = (float)x1[2], k3 = (float)x1[3]; \
            const float g0 = (float)x1[4], g1 = (float)x1[5], g2 = (float)x1[6], g3 = (float)x1[7]; \
            const float r0 = (float)x0[0], r1 = (float)x0[1], r2 = (float)x0[2], r3 = (float)x0[3]; \
            const float p0 = (float)x0[4], p1 = (float)x0[5], p2 = (float)x0[6], p3 = (float)x0[7]; \
            float sa = (a0 * k0 + a1 * k1) + (a2 * k2 + a3 * k3), sb = (b0 * k0 + b1 * k1) + (b2 * k2 + b3 * k3); \
            sa += dppf<0x128>(sa); sb += dppf<0x128>(sb); sa += dppf<0x124>(sa); sb += dppf<0x124>(sb); \
            sa += dppf<0x122>(sa); sb += dppf<0x122>(sb); sa += dppf<0x121>(sa); sb += dppf<0x121>(sb); \
            a0 = (a0 * d[0] + va * p0) - sa * g0; a1 = (a1 * d[1] + va * p1) - sa * g1; a2 = (a2 * d[2] + va * p2) - sa * g2; a3 = (a3 * d[3] + va * p3) - sa * g3; \
            b0 = (b0 * d[0] + vb * p0) - sb * g0; b1 = (b1 * d[1] + vb * p1) - sb * g1; b2 = (b2 * d[2] + vb * p2) - sb * g2; b3 = (b3 * d[3] + vb * p3) - sb * g3; \
            float y1 = (a0 * r0 + a1 * r1) + (a2 * r2 + a3 * r3), y2 = (b0 * r0 + b1 * r1) + (b2 * r2 + b3 * r3); \
            y1 += dppf<0x128>(y1); y2 += dppf<0x128>(y2); y1 += dppf<0x124>(y1); y2 += dppf<0x124>(y2); \
            y1 += dppf<0x122>(y1); y2 += dppf<0x122>(y2); y1 += dppf<0x121>(y1); y2 += dppf<0x121>(y2); \
            ya[q] = y1; yb[q] = y2; } \
            if (jg == 0) { _Pragma("unroll") for (int q = 0; q < 4; ++q) if ((tb) + q < SEQ) *(float2*)(Yp + (size_t)((tb) + q) * 512) = make_float2(ya[q], yb[q]); } }
        SCAN_LOAD(A, 0); SCAN_LOAD(Bf, 4);
        for (int t0 = 0; t0 < SEQ; t0 += 12) {
            SCAN_LOAD(C, t0 + 8);
            SCAN_STEP(A, t0);
            SCAN_LOAD(A, t0 + 12);
            SCAN_STEP(Bf, t0 + 4);
            SCAN_LOAD(Bf, t0 + 16);
            SCAN_STEP(C, t0 + 8);
        }
#undef SCAN_LOAD
#undef SCAN_STEP
    }
}

__device__ __forceinline__ unsigned fkey(float f) { const unsigned u = __float_as_uint(f); return (u & 0x80000000u) ? ~u : (u | 0x80000000u); }

#define HSTRIDE 2112
__device__ __forceinline__ void phase_indexer(const Params& p, unsigned char* lds, int blk0, int nblk) {
    unsigned* S = (unsigned*)lds;
    unsigned* hist = (unsigned*)(lds + 131072);
    int* misc = (int*)(lds + 131072 + 2 * HSTRIDE * 4);
    unsigned char* ws = p.ws;
    const half_t* QI = (const half_t*)(ws + OFF_QI);
    const half_t* KI = (const half_t*)(ws + OFF_KI);
    const float* WI = (const float*)(ws + OFF_WI);
    u16* SEL = (u16*)(ws + OFF_SEL);
    const int tid = threadIdx.x, lane = tid & 63, wid = tid >> 6, r31 = lane & 31, hh = lane >> 5;
    const int bx = (int)blockIdx.x - blk0;
    if (bx < 0 || bx >= nblk) return;
    const int hr = (r31 >> 2) & 1, ir = (r31 & 3) + 4 * (r31 >> 3), qr = 2 * hr + (ir >> 3), hdr = ir & 7;
    h8 afn[4]; f4 wn0, wn1, wn2, wn3;
#define IDX_FETCH(task_) { const int tk_ = (task_) < 8192 ? (task_) : bx; const int r0_ = (tk_ & 3) * SEQ + (tk_ >> 2) * 4; \
        const half_t* qp_ = QI + (size_t)(r0_ + qr) * 512 + hdr * 64 + 8 * hh; \
        _Pragma("unroll") for (int ks = 0; ks < 4; ++ks) afn[ks] = *(const h8*)(qp_ + ks * 16); \
        wn0 = *(const f4*)(WI + (size_t)(r0_ + 2 * hh) * 8); wn1 = *(const f4*)(WI + (size_t)(r0_ + 2 * hh) * 8 + 4); \
        wn2 = *(const f4*)(WI + (size_t)(r0_ + 2 * hh + 1) * 8); wn3 = *(const f4*)(WI + (size_t)(r0_ + 2 * hh + 1) * 8 + 4); }
    IDX_FETCH(bx)
    for (int task = bx; task < 8192; task += nblk) {
        const int b = task & 3, t0 = (task >> 2) * 4, row0 = b * SEQ + t0;
        u16* sel = SEL + (size_t)row0 * 256;
        h8 af[4];
#pragma unroll
        for (int ks = 0; ks < 4; ++ks) af[ks] = afn[ks];
        const f4 wa0 = wn0, wa1 = wn1, wb0 = wn2, wb1 = wn3;
        if (t0 < 256) {
            for (int idx = tid; idx < 1024; idx += NTHREADS) { const int q = idx >> 8, j = idx & 255; sel[idx] = (j <= t0 + q) ? (u16)j : (u16)0xFFFF; }
            IDX_FETCH(task + nblk)
            continue;
        }
        const int nc = (t0 + 4 + 31) >> 5, nn = nc * 32;
        const int ta = t0 + 2 * hh, tb = ta + 1;
        const half_t* kbase = KI + (size_t)b * SEQ * 64 + 8 * hh;
        {
            h8 bA[4][4], bB[4][4];
#define SC_LOAD(buf, cs) { _Pragma("unroll") for (int u = 0; u < 4; ++u) { int c = (cs) + 8 * u; c = c < nc ? c : nc - 1; const half_t* kp = kbase + (size_t)(c * 32 + r31) * 64; \
                _Pragma("unroll") for (int ks = 0; ks < 4; ++ks) buf[u][ks] = *(const h8*)(kp + ks * 16); } }
#define SC_PROC(buf, cs) { _Pragma("unroll") for (int u = 0; u < 4; ++u) { const int c = (cs) + 8 * u; if (c < nc) { const int s = c * 32 + r31; \
                f16v acc; _Pragma("unroll") for (int e = 0; e < 16; ++e) acc[e] = 0.f; \
                _Pragma("unroll") for (int ks = 0; ks < 4; ++ks) acc = __builtin_amdgcn_mfma_f32_32x32x16_f16(af[ks], buf[u][ks], acc, 0, 0, 0); \
                float sa0 = 0.f, sa1 = 0.f, sb0 = 0.f, sb1 = 0.f; \
                _Pragma("unroll") for (int e = 0; e < 4; ++e) { sa0 += wa0[e] * fmaxf(acc[e], 0.f); sa1 += wa1[e] * fmaxf(acc[4 + e], 0.f); sb0 += wb0[e] * fmaxf(acc[8 + e], 0.f); sb1 += wb1[e] * fmaxf(acc[12 + e], 0.f); } \
                S[(2 * hh) * 8192 + s] = (s <= ta) ? fkey(sa0 + sa1) : 0u; S[(2 * hh + 1) * 8192 + s] = (s <= tb) ? fkey(sb0 + sb1) : 0u; } } }
            SC_LOAD(bA, wid)
            for (int c0 = wid; c0 < nc; c0 += 64) {
                SC_LOAD(bB, c0 + 32)
                SC_PROC(bA, c0)
                SC_LOAD(bA, c0 + 64)
                SC_PROC(bB, c0 + 32)
            }
#undef SC_LOAD
#undef SC_PROC
        }
        IDX_FETCH(task + nblk)
        __syncthreads();
        unsigned T0 = 0, T1 = 0, T2 = 0, T3 = 0, pmask = 0; int k0 = 256, k1 = 256, k2 = 256, k3 = 256;
#pragma unroll 1
        for (int pass = 0; pass < 3; ++pass) {
            const int shift = pass == 0 ? 21 : (pass == 1 ? 10 : 0);
            const unsigned dmask = pass == 2 ? 1023u : 2047u;
            for (int i = tid; i < 2 * HSTRIDE; i += NTHREADS) hist[i] = 0u;
            __syncthreads();
            for (int s = tid; s < nn; s += NTHREADS) {
                const unsigned key0 = S[s], key1 = S[8192 + s], key2 = S[16384 + s], key3 = S[24576 + s];
                if ((key0 & pmask) == T0) { const unsigned bin = (key0 >> shift) & dmask; atomicAdd(&hist[bin + (bin >> 5)], 1u); }
                if ((key1 & pmask) == T1) { const unsigned bin = (key1 >> shift) & dmask; atomicAdd(&hist[bin + (bin >> 5)], 65536u); }
                if ((key2 & pmask) == T2) { const unsigned bin = (key2 >> shift) & dmask; atomicAdd(&hist[HSTRIDE + bin + (bin >> 5)], 1u); }
                if ((key3 & pmask) == T3) { const unsigned bin = (key3 >> shift) & dmask; atomicAdd(&hist[HSTRIDE + bin + (bin >> 5)], 65536u); }
            }
            __syncthreads();
            if (wid < 4) {
                const unsigned* hb = hist + (wid >> 1) * HSTRIDE + 33 * lane;
                const int sh = (wid & 1) * 16;
                const int kl = wid == 0 ? k0 : (wid == 1 ? k1 : (wid == 2 ? k2 : k3));
                int tot = 0;
#pragma unroll 8
                for (int i = 0; i < 32; ++i) tot += (int)((hb[i] >> sh) & 0xFFFFu);
                int v = tot;
#pragma unroll
                for (int off = 1; off < 64; off <<= 1) { const int o = __shfl_down(v, off); if (lane + off < 64) v += o; }
                const int sufx = v - tot;
                const unsigned long long fb = __ballot(sufx < kl && kl <= sufx + tot);
                const int L = (int)__builtin_ctzll(fb);
                const int kk = kl - __builtin_amdgcn_readlane(sufx, L);
                const unsigned cw = lane < 32 ? hist[(wid >> 1) * HSTRIDE + 33 * L + lane] : 0u;
                const int c = (int)((cw >> sh) & 0xFFFFu);
                int ci = c;
#pragma unroll
                for (int off = 1; off < 64; off <<= 1) { const int o = __shfl_down(ci, off); if (lane + off < 64) ci += o; }
                const int cx = ci - c;
                if (cx < kk && kk <= cx + c) { misc[2 * wid] = 32 * L + lane; misc[2 * wid + 1] = kk - cx; misc[8 + wid] = (c == kk - cx) ? 1 : 0; }
            }
            __syncthreads();
            T0 |= (unsigned)misc[0] << shift; k0 = misc[1];
            T1 |= (unsigned)misc[2] << shift; k1 = misc[3];
            T2 |= (unsigned)misc[4] << shift; k2 = misc[5];
            T3 |= (unsigned)misc[6] << shift; k3 = misc[7];
            pmask |= dmask << shift;
            if (pass == 1 && (misc[8] & misc[9] & misc[10] & misc[11])) break;
        }
        const int cl = (((nn + 7) >> 3) + 63) & ~63;
        const int slo = wid * cl, shi = min(nn, slo + cl);
        int* cnt = misc + 32;
        {
            int cg0 = 0, cg1 = 0, cg2 = 0, cg3 = 0, ce0 = 0, ce1 = 0, ce2 = 0, ce3 = 0;
            for (int sb0 = slo; sb0 < shi; sb0 += 64) {
                const int s = sb0 + lane; const bool in = s < shi;
                const unsigned x0 = in ? (S[s] & pmask) : 0u, x1 = in ? (S[8192 + s] & pmask) : 0u, x2 = in ? (S[16384 + s] & pmask) : 0u, x3 = in ? (S[24576 + s] & pmask) : 0u;
                cg0 += __popcll(__ballot(x0 > T0)); ce0 += __popcll(__ballot(x0 == T0));
                cg1 += __popcll(__ballot(x1 > T1)); ce1 += __popcll(__ballot(x1 == T1));
                cg2 += __popcll(__ballot(x2 > T2)); ce2 += __popcll(__ballot(x2 == T2));
                cg3 += __popcll(__ballot(x3 > T3)); ce3 += __popcll(__ballot(x3 == T3));
            }
            if (lane == 0) {
                cnt[(0 * 8 + wid) * 2] = cg0; cnt[(0 * 8 + wid) * 2 + 1] = ce0; cnt[(1 * 8 + wid) * 2] = cg1; cnt[(1 * 8 + wid) * 2 + 1] = ce1;
                cnt[(2 * 8 + wid) * 2] = cg2; cnt[(2 * 8 + wid) * 2 + 1] = ce2; cnt[(3 * 8 + wid) * 2] = cg3; cnt[(3 * 8 + wid) * 2 + 1] = ce3;
            }
        }
        __syncthreads();
        {
            const unsigned long long ltmask = (1ull << lane) - 1ull;
            int og0 = 0, og1 = 0, og2 = 0, og3 = 0, oe0 = 0, oe1 = 0, oe2 = 0, oe3 = 0;
#pragma unroll
            for (int w = 0; w < 8; ++w) if (w < wid) {
                og0 += cnt[(0 * 8 + w) * 2]; oe0 += cnt[(0 * 8 + w) * 2 + 1]; og1 += cnt[(1 * 8 + w) * 2]; oe1 += cnt[(1 * 8 + w) * 2 + 1];
                og2 += cnt[(2 * 8 + w) * 2]; oe2 += cnt[(2 * 8 + w) * 2 + 1]; og3 += cnt[(3 * 8 + w) * 2]; oe3 += cnt[(3 * 8 + w) * 2 + 1];
            }
#define WR1(q, xq, Tq, kq, og, oe) { const bool gt = xq > Tq, eq = xq == Tq; const unsigned long long bg = __ballot(gt), be = __ballot(eq); u16* so = sel + q * 256; \
                if (gt) { const int pos = og + __popcll(bg & ltmask); if (pos < 256) so[pos] = (u16)s; } \
                if (eq) { const int rk = oe + __popcll(be & ltmask); if (rk < kq) so[(256 - kq) + rk] = (u16)s; } \
                og += __popcll(bg); oe += __popcll(be); }
            for (int sb0 = slo; sb0 < shi; sb0 += 64) {
                const int s = sb0 + lane; const bool in = s < shi;
                const unsigned x0 = in ? (S[s] & pmask) : 0u, x1 = in ? (S[8192 + s] & pmask) : 0u, x2 = in ? (S[16384 + s] & pmask) : 0u, x3 = in ? (S[24576 + s] & pmask) : 0u;
                WR1(0, x0, T0, k0, og0, oe0) WR1(1, x1, T1, k1, og1, oe1) WR1(2, x2, T2, k2, og2, oe2) WR1(3, x3, T3, k3, og3, oe3)
            }
#undef WR1
        }
        __syncthreads();
    }
}

__device__ __forceinline__ void phase_post(const Params& p) {
    unsigned char* ws = p.ws;
    const float* YR = (const float*)(ws + OFF_YRAW);
    const half_t* VS = (const half_t*)(ws + OFF_VS);
    const half_t* G = (const half_t*)(ws + OFF_G);
    const float* RK = (const float*)(ws + OFF_RK);
    half_t* YA = (half_t*)(ws + OFF_D);
    const float* lg = p.in[I_LNG]; const float* lb = p.in[I_LNB];
    for (int i = blockIdx.x * NTHREADS + threadIdx.x; i < NTOK * 128; i += gridDim.x * NTHREADS) {
        const int m = i >> 7, n = (i & 127) * 4, h = n >> 6;
        const f4 y = *(const f4*)(YR + (size_t)m * 512 + n);
        const float mean = rowsum16(y[0] + y[1] + y[2] + y[3]) * (1.0f / 64.0f);
        const float d0 = y[0] - mean, d1 = y[1] - mean, d2 = y[2] - mean, d3 = y[3] - mean;
        const float var = rowsum16(d0 * d0 + d1 * d1 + d2 * d2 + d3 * d3) * (1.0f / 64.0f);
        const float rs = rsqrtf(var + 64e-5f);
        const f4 g4 = *(const f4*)(lg + n), b4 = *(const f4*)(lb + n);
        const h4 v4 = *(const h4*)(VS + (size_t)m * 512 + n), gg = *(const h4*)(G + (size_t)m * 512 + n);
        const float rk = RK[(size_t)m * 8 + h];
        const float o0 = (d0 * rs * g4[0] + b4[0] + rk * (float)v4[0]) * (float)gg[0];
        const float o1 = (d1 * rs * g4[1] + b4[1] + rk * (float)v4[1]) * (float)gg[1];
        const float o2 = (d2 * rs * g4[2] + b4[2] + rk * (float)v4[2]) * (float)gg[2];
        const float o3 = (d3 * rs * g4[3] + b4[3] + rk * (float)v4[3]) * (float)gg[3];
        *(h4*)(YA + (size_t)m * 512 + n) = pack4(o0, o1, o2, o3);
    }
}

__device__ __forceinline__ float dot8h(const h8 a, const h8 b) {
#if __has_builtin(__builtin_amdgcn_fdot2)
    float d = 0.f;
    d = __builtin_amdgcn_fdot2((h2){a[0], a[1]}, (h2){b[0], b[1]}, d, false);
    d = __builtin_amdgcn_fdot2((h2){a[2], a[3]}, (h2){b[2], b[3]}, d, false);
    d = __builtin_amdgcn_fdot2((h2){a[4], a[5]}, (h2){b[4], b[5]}, d, false);
    d = __builtin_amdgcn_fdot2((h2){a[6], a[7]}, (h2){b[6], b[7]}, d, false);
    return d;
#else
    float d = 0.f;
#pragma unroll
    for (int e = 0; e < 8; ++e) d += (float)a[e] * (float)b[e];
    return d;
#endif
}

__device__ __forceinline__ void phase_attn(const Params& p, unsigned char* lds, int blk0, int nblk) {
    unsigned char* ws = p.ws;
    const half_t* Q = (const half_t*)(ws + OFF_Q);
    const half_t* KH = (const half_t*)(ws + OFF_KH);
    const half_t* VH = (const half_t*)(ws + OFF_VH);
    const u16* SEL = (const u16*)(ws + OFF_SEL);
    half_t* YB = (half_t*)(ws + OFF_YB);
    const int tid = threadIdx.x, lane = tid & 63, wid = tid >> 6, g = lane >> 3, dq = lane & 7;
    int* offs = (int*)(lds + wid * 1024);
    const int bx = (int)blockIdx.x - blk0;
    if (bx < 0 || bx >= nblk) return;
    const int cls = blockIdx.x & 7;
    const int first = (cls - (blk0 & 7) + 8) & 7;
    const int ncls = (nblk - first + 7) >> 3;
    const int ib = (bx - first) >> 3;
    const int wv = ib * 8 + wid, nwv = ncls * 8;
    for (int bhi = 0; bhi < 4; ++bhi) {
        const int bh = cls + 8 * bhi, b = bh >> 3, h = bh & 7;
        const unsigned char* Kb = (const unsigned char*)(KH + (size_t)bh * SEQ * 64);
        const unsigned char* Vb = (const unsigned char*)(VH + (size_t)bh * SEQ * 64);
        int t = wv;
        unsigned sraw[4]; h8 qn;
#pragma unroll
        for (int e = 0; e < 8; ++e) qn[e] = (half_t)0.f;
#pragma unroll
        for (int i = 0; i < 4; ++i) sraw[i] = 0;
        if (t < SEQ) {
            const size_t row = (size_t)b * SEQ + t;
#pragma unroll
            for (int i = 0; i < 4; ++i) sraw[i] = SEL[row * 256 + lane + 64 * i];
            qn = *(const h8*)(Q + row * 512 + h * 64 + dq * 8);
        }
        for (; t < SEQ; t += nwv) {
            const size_t row = (size_t)b * SEQ + t;
#pragma unroll
            for (int i = 0; i < 4; ++i) { const unsigned idx = sraw[i] > 8191u ? 0u : sraw[i]; offs[lane + 64 * i] = (int)idx * 128; }
            const h8 q8 = qn;
            const int tn = t + nwv;
            if (tn < SEQ) {
                const size_t rown = (size_t)b * SEQ + tn;
#pragma unroll
                for (int i = 0; i < 4; ++i) sraw[i] = SEL[rown * 256 + lane + 64 * i];
                qn = *(const h8*)(Q + rown * 512 + h * 64 + dq * 8);
            }
            __builtin_amdgcn_wave_barrier();
            asm volatile("s_waitcnt lgkmcnt(0)" ::: "memory");
            unsigned of[32];
#pragma unroll
            for (int it = 0; it < 32; ++it) of[it] = (unsigned)offs[it * 8 + g] + (unsigned)dq * 16u;
            h8 kr[32];
#pragma unroll
            for (int it = 0; it < 32; ++it) kr[it] = *(const h8*)(Kb + of[it]);
            float lg[32];
            float mx = -INFINITY;
#pragma unroll
            for (int it = 0; it < 32; ++it) {
                float d = sum8(dot8h(q8, kr[it]));
                d = (it * 8 + g <= t) ? d : -INFINITY;
                lg[it] = d; mx = fmaxf(mx, d);
            }
            asm volatile("" : "+v"(mx) :: "memory");
            h8 vr[32];
#pragma unroll
            for (int it = 0; it < 32; ++it) vr[it] = *(const h8*)(Vb + of[it]);
            mx = fmaxf(mx, __shfl_xor(mx, 8)); mx = fmaxf(mx, __shfl_xor(mx, 16)); mx = fmaxf(mx, __shfl_xor(mx, 32));
            float sum = 0.f;
#pragma unroll
            for (int it = 0; it < 32; ++it) { lg[it] = __expf(lg[it] - mx); sum += lg[it]; }
            sum += __shfl_xor(sum, 8); sum += __shfl_xor(sum, 16); sum += __shfl_xor(sum, 32);
            float o[8];
#pragma unroll
            for (int e = 0; e < 8; ++e) o[e] = 0.f;
#pragma unroll
            for (int it = 0; it < 32; ++it)
#pragma unroll
                for (int e = 0; e < 8; ++e) o[e] += lg[it] * (float)vr[it][e];
            const float inv = 1.0f / sum;
#pragma unroll
            for (int e = 0; e < 8; ++e) { o[e] += __shfl_xor(o[e], 8); o[e] += __shfl_xor(o[e], 16); o[e] += __shfl_xor(o[e], 32); }
            if (g == 0) {
                h8 w;
#pragma unroll
                for (int e = 0; e < 8; ++e) w[e] = (half_t)(o[e] * inv);
                *(h8*)(YB + row * 512 + h * 64 + dq * 8) = w;
            }
            __builtin_amdgcn_wave_barrier();
        }
    }
}

__device__ __forceinline__ void phase_merge(const Params& p, unsigned char* lds) {
    unsigned char* ws = p.ws;
    const half_t* U = (const half_t*)(ws + OFF_U16);
    const half_t* WG = (const half_t*)(ws + OFF_WG);
    const half_t* YA = (const half_t*)(ws + OFF_D);
    const half_t* YB = (const half_t*)(ws + OFF_YB);
    half_t* MG = (half_t*)(ws + OFF_Q);
    const int tid = threadIdx.x, lane = tid & 63, wid = tid >> 6, wm = wid >> 1, wn = wid & 1, r31 = lane & 31, hh = lane >> 5;
    XCD_TILE_LOOP(8) {
        int mt, nt; xcd_tile(L_, 8, mt, nt); const int m0 = mt * 256, n0 = nt * 128;
        unsigned sg[2][2][8], mg[2][2][8];
        {
            f16v acc[2][2];
            gemm_main<2>(acc, U, 1024, WG, 1024, 1024, m0, n0, lds);
#pragma unroll
            for (int mi = 0; mi < 2; ++mi)
#pragma unroll
                for (int nj = 0; nj < 2; ++nj) {
#pragma unroll
                    for (int e = 0; e < 8; ++e) { h2 w; w[0] = (half_t)sigm(acc[mi][nj][2 * e]); w[1] = (half_t)sigm(acc[mi][nj][2 * e + 1]); sg[mi][nj][e] = __builtin_bit_cast(unsigned, w); }
                    asm volatile("" : "+v"(sg[mi][nj][0]), "+v"(sg[mi][nj][1]), "+v"(sg[mi][nj][2]), "+v"(sg[mi][nj][3]), "+v"(sg[mi][nj][4]), "+v"(sg[mi][nj][5]), "+v"(sg[mi][nj][6]), "+v"(sg[mi][nj][7]));
                }
        }
        {
            f16v acc[2][2];
            gemm_main<2>(acc, YA, 512, (const half_t*)(ws + OFF_WOR), 512, 512, m0, n0, lds);
#pragma unroll
            for (int mi = 0; mi < 2; ++mi)
#pragma unroll
                for (int nj = 0; nj < 2; ++nj) {
#pragma unroll
                    for (int e = 0; e < 8; ++e) { const h2 s2 = __builtin_bit_cast(h2, sg[mi][nj][e]); h2 w; w[0] = (half_t)(acc[mi][nj][2 * e] * (float)s2[0]); w[1] = (half_t)(acc[mi][nj][2 * e + 1] * (float)s2[1]); mg[mi][nj][e] = __builtin_bit_cast(unsigned, w); }
                    asm volatile("" : "+v"(mg[mi][nj][0]), "+v"(mg[mi][nj][1]), "+v"(mg[mi][nj][2]), "+v"(mg[mi][nj][3]), "+v"(mg[mi][nj][4]), "+v"(mg[mi][nj][5]), "+v"(mg[mi][nj][6]), "+v"(mg[mi][nj][7]));
                }
        }
        {
            f16v acc[2][2];
            gemm_main<2>(acc, U, 1024, WG + (size_t)1024 * 1024, 1024, 1024, m0, n0, lds);
#pragma unroll
            for (int mi = 0; mi < 2; ++mi)
#pragma unroll
                for (int nj = 0; nj < 2; ++nj) {
#pragma unroll
                    for (int e = 0; e < 8; ++e) { h2 w; w[0] = (half_t)sigm(acc[mi][nj][2 * e]); w[1] = (half_t)sigm(acc[mi][nj][2 * e + 1]); sg[mi][nj][e] = __builtin_bit_cast(unsigned, w); }
                    asm volatile("" : "+v"(sg[mi][nj][0]), "+v"(sg[mi][nj][1]), "+v"(sg[mi][nj][2]), "+v"(sg[mi][nj][3]), "+v"(sg[mi][nj][4]), "+v"(sg[mi][nj][5]), "+v"(sg[mi][nj][6]), "+v"(sg[mi][nj][7]));
                }
        }
        {
            f16v acc[2][2];
            gemm_main<2>(acc, YB, 512, (const half_t*)(ws + OFF_WOA), 512, 512, m0, n0, lds);
#pragma unroll
            for (int mi = 0; mi < 2; ++mi) {
                const int m = m0 + wm * 64 + mi * 32 + r31;
#pragma unroll
                for (int nj = 0; nj < 2; ++nj)
#pragma unroll
                    for (int rg = 0; rg < 4; ++rg) {
                        const int n = n0 + wn * 64 + nj * 32 + rg * 8 + hh * 4;
                        float o[4];
#pragma unroll
                        for (int e = 0; e < 4; ++e) { const int r = rg * 4 + e; const h2 m2 = __builtin_bit_cast(h2, mg[mi][nj][r >> 1]), s2 = __builtin_bit_cast(h2, sg[mi][nj][r >> 1]); o[e] = (float)m2[r & 1] + acc[mi][nj][r] * (float)s2[r & 1]; }
                        *(h4*)(MG + (size_t)m * 1024 + n) = pack4(o[0], o[1], o[2], o[3]);
                    }
            }
        }
    }
}

__device__ __forceinline__ void phase_outproj(const Params& p, unsigned char* lds) {
    const half_t* MG = (const half_t*)(p.ws + OFF_Q);
    const half_t* W = (const half_t*)(p.ws + OFF_WOUT);
    const float* x = p.in[I_X];
    const int tid = threadIdx.x, lane = tid & 63, wid = tid >> 6, wm = wid >> 1, wn = wid & 1, r31 = lane & 31, hh = lane >> 5;
    XCD_TILE_LOOP(4) {
        int mt, nt; xcd_tile(L_, 4, mt, nt); const int m0 = mt * 256, n0 = nt * 256;
        f16v acc[2][4];
        gemm_main<4>(acc, MG, 1024, W, 1024, 1024, m0, n0, lds);
#pragma unroll
        for (int mi = 0; mi < 2; ++mi) {
            const int m = m0 + wm * 64 + mi * 32 + r31;
#pragma unroll
            for (int nj = 0; nj < 4; ++nj)
#pragma unroll
                for (int rg = 0; rg < 4; ++rg) {
                    const size_t o = (size_t)m * 1024 + n0 + wn * 128 + nj * 32 + rg * 8 + hh * 4;
                    f4 v = *(const f4*)(x + o);
                    v[0] += acc[mi][nj][rg * 4]; v[1] += acc[mi][nj][rg * 4 + 1]; v[2] += acc[mi][nj][rg * 4 + 2]; v[3] += acc[mi][nj][rg * 4 + 3];
                    *(f4*)(p.out + o) = v;
                }
        }
    }
}

__device__ __forceinline__ void phase_ffn1(const Params& p, unsigned char* lds) {
    const half_t* U = (const half_t*)(p.ws + OFF_U16);
    const half_t* W = (const half_t*)(p.ws + OFF_WF1);
    half_t* ACT = (half_t*)(p.ws + OFF_PR);
    const int tid = threadIdx.x, lane = tid & 63, wid = tid >> 6, wm = wid >> 1, wn = wid & 1, r31 = lane & 31, hh = lane >> 5;
    XCD_TILE_LOOP(22) {
        int mt, nt; xcd_tile(L_, 22, mt, nt); const int m0 = mt * 256, n0 = nt * 256;
        f16v acc[2][4];
        gemm_main<4>(acc, U, 1024, W, 1024, 1024, m0, n0, lds);
#pragma unroll
        for (int mi = 0; mi < 2; ++mi) {
            const int m = m0 + wm * 64 + mi * 32 + r31;
#pragma unroll
            for (int pr = 0; pr < 2; ++pr)
#pragma unroll
                for (int rg = 0; rg < 4; ++rg) {
                    const int c = ((n0 + wn * 128) >> 1) + pr * 32 + rg * 8 + hh * 4;
                    float o[4];
#pragma unroll
                    for (int e = 0; e < 4; ++e) { const float gt = acc[mi][2 * pr][rg * 4 + e], up = acc[mi][2 * pr + 1][rg * 4 + e]; o[e] = gt * sigm(gt) * up; }
                    *(h4*)(ACT + (size_t)m * 2816 + c) = pack4(o[0], o[1], o[2], o[3]);
                }
        }
    }
}

__device__ __forceinline__ void phase_ffn2(const Params& p, unsigned char* lds) {
    const half_t* ACT = (const half_t*)(p.ws + OFF_PR);
    const half_t* W = (const half_t*)(p.ws + OFF_WF2);
    const int tid = threadIdx.x, lane = tid & 63, wid = tid >> 6, wm = wid >> 1, wn = wid & 1, r31 = lane & 31, hh = lane >> 5;
    XCD_TILE_LOOP(4) {
        int mt, nt; xcd_tile(L_, 4, mt, nt); const int m0 = mt * 256, n0 = nt * 256;
        f16v acc[2][4];
        gemm_main<4>(acc, ACT, 2816, W, 2816, 2816, m0, n0, lds);
#pragma unroll
        for (int mi = 0; mi < 2; ++mi) {
            const int m = m0 + wm * 64 + mi * 32 + r31;
#pragma unroll
            for (int nj = 0; nj < 4; ++nj)
#pragma unroll
                for (int rg = 0; rg < 4; ++rg) {
                    const size_t o = (size_t)m * 1024 + n0 + wn * 128 + nj * 32 + rg * 8 + hh * 4;
                    f4 v = *(const f4*)(p.out + o);
                    v[0] += acc[mi][nj][rg * 4]; v[1] += acc[mi][nj][rg * 4 + 1]; v[2] += acc[mi][nj][rg * 4 + 2]; v[3] += acc[mi][nj][rg * 4 + 3];
                    *(f4*)(p.out + o) = v;
                }
        }
    }
}

__device__ __forceinline__ void phase_final(const Params& p) {
    const int lane = threadIdx.x & 63, wid = threadIdx.x >> 6;
    const float* g = p.in[I_NFG];
    for (int row = blockIdx.x * 8 + wid; row < NTOK; row += gridDim.x * 8) {
        f4* xr = (f4*)(p.out + (size_t)row * 1024);
        f4 v[4]; float ss = 0.f;
#pragma unroll
        for (int i = 0; i < 4; ++i) { v[i] = xr[lane + 64 * i]; ss += v[i][0] * v[i][0] + v[i][1] * v[i][1] + v[i][2] * v[i][2] + v[i][3] * v[i][3]; }
        ss = wave_sum(ss);
        const float rs = rsqrtf(ss * (1.0f / 1024.0f) + 1e-6f);
#pragma unroll
        for (int i = 0; i < 4; ++i) {
            const f4 gg = ((const f4*)g)[lane + 64 * i];
            f4 w; w[0] = v[i][0] * rs * gg[0]; w[1] = v[i][1] * rs * gg[1]; w[2] = v[i][2] * rs * gg[2]; w[3] = v[i][3] * rs * gg[3];
            xr[lane + 64 * i] = w;
        }
    }
}

#define NPHASES 13
__global__ void __launch_bounds__(NTHREADS) mk_fwd(Params p, int ph_lo, int ph_hi, int coop) {
    extern __shared__ __attribute__((aligned(16))) unsigned char lds[];
    cg::grid_group grid = cg::this_grid();
#define PHASE(id, body) if (ph_lo <= id && id < ph_hi) { int reps_ = (id == PROBE_DUP) ? 2 : 1; if (id == PROBE_DUP) asm volatile("" : "+s"(reps_)); _Pragma("nounroll") for (int rep_ = 0; rep_ < reps_; ++rep_) { body; if (rep_ + 1 < reps_) grid.sync(); } if (coop && id + 1 < ph_hi) grid.sync(); }
    PHASE(0, phase_convert(p, lds))
    PHASE(1, phase_inproj(p, lds))
    PHASE(2, phase_prep(p))
    PHASE(3, phase_lora(p, lds))
    PHASE(4, { if (blockIdx.x < 64) phase_scan(p); else phase_indexer(p, lds, 64, (int)gridDim.x - 64); })
    PHASE(6, { phase_post(p); phase_attn(p, lds, 0, gridDim.x); })
    PHASE(7, phase_merge(p, lds))
    PHASE(8, phase_outproj(p, lds))
    PHASE(9, rmsnorm_rows_f16(p.out, p.in[I_N2G], (half_t*)(p.ws + OFF_U16)))
    PHASE(10, phase_ffn1(p, lds))
    PHASE(11, phase_ffn2(p, lds))
    PHASE(12, phase_final(p))
#undef PHASE
}

#ifndef MK_COOP
#define MK_COOP 1
#endif

extern "C" void kernel_launch(void* const* d_in, const int* in_sizes, int n_in, void* d_out, int out_size, void* d_ws, size_t ws_size, hipStream_t stream) {
    static int grid = 0;
    if (grid == 0) {
        if (n_in != 21 || out_size != NTOK * 1024 || ws_size < WS_END) { fprintf(stderr, "kernel_launch: unexpected shapes (n_in %d out %d ws %zu, need %zu)\n", n_in, out_size, ws_size, (size_t)WS_END); grid = -1; return; }
        int dev = 0, cus = 0, per_cu = 0;
        (void)hipGetDevice(&dev);
        (void)hipDeviceGetAttribute(&cus, hipDeviceAttributeMultiprocessorCount, dev);
        if (hipFuncSetAttribute((const void*)mk_fwd, hipFuncAttributeMaxDynamicSharedMemorySize, LDS_BYTES) != hipSuccess) { fprintf(stderr, "kernel_launch: hipFuncSetAttribute failed\n"); grid = -1; return; }
        if (hipOccupancyMaxActiveBlocksPerMultiprocessor(&per_cu, (const void*)mk_fwd, NTHREADS, LDS_BYTES) != hipSuccess || per_cu < 1) { fprintf(stderr, "kernel_launch: occupancy query gave %d\n", per_cu); per_cu = 1; }
        (void)hipGetLastError();
        grid = cus * per_cu;
        grid &= ~7;
        if (grid < 72) grid = 72;
    }
    if (grid < 0) return;
    Params p;
    memset(&p, 0, sizeof(p));
    for (int i = 0; i < 21; ++i) p.in[i] = (const float*)d_in[i];
    p.out = (float*)d_out; p.ws = (unsigned char*)d_ws;
    for (int j = 0; j < 32; ++j) p.invf[j] = pow(10000.0, -(double)j / 32.0);
#if MK_COOP
    int lo = 0, hi = NPHASES, coop = 1;
    void* args[] = {&p, &lo, &hi, &coop};
    hipError_t e = hipLaunchCooperativeKernel((const void*)mk_fwd, dim3(grid), dim3(NTHREADS), args, LDS_BYTES, stream);
    if (e != hipSuccess) fprintf(stderr, "cooperative launch failed: %s (grid %d)\n", hipGetErrorString(e), grid);
#else
    for (int ph = 0; ph < NPHASES; ++ph)
        hipLaunchKernelGGL(mk_fwd, dim3(grid), dim3(NTHREADS), LDS_BYTES, stream, p, ph, ph + 1, 0);
#endif
}
```

```cpp
#include <hip/hip_runtime.h>
#include <hip/hip_cooperative_groups.h>
#include <cstdio>
#include <cmath>
#include <cstring>
namespace cg = cooperative_groups;

typedef _Float16 half_t;
typedef _Float16 h8 __attribute__((ext_vector_type(8)));
typedef _Float16 h4 __attribute__((ext_vector_type(4)));
typedef _Float16 h2 __attribute__((ext_vector_type(2)));
typedef float f16v __attribute__((ext_vector_type(16)));
typedef float f4 __attribute__((ext_vector_type(4)));
typedef unsigned short u16;
typedef unsigned u32x4 __attribute__((ext_vector_type(4)));
typedef int i32x4 __attribute__((ext_vector_type(4)));

#define NTOK 32768
#define SEQ 8192
#define NTHREADS 512
#ifndef PROBE_DUP
#define PROBE_DUP -1
#endif
#ifndef LORA_PARTS
#define LORA_PARTS 7
#endif
#define LDS_BYTES 151552

constexpr size_t OFF_WIN  = 0;
constexpr size_t OFF_WG   = OFF_WIN  + 8388608;
constexpr size_t OFF_WD   = OFF_WG   + 4194304;
constexpr size_t OFF_AUP  = OFF_WD   + 65536;
constexpr size_t OFF_GUP  = OFF_AUP  + 65536;
constexpr size_t OFF_WOR  = OFF_GUP  + 131072;
constexpr size_t OFF_WOA  = OFF_WOR  + 1048576;
constexpr size_t OFF_WOUT = OFF_WOA  + 1048576;
constexpr size_t OFF_WF1  = OFF_WOUT + 2097152;
constexpr size_t OFF_WF2  = OFF_WF1  + 11534336;
constexpr size_t OFF_ROPE = OFF_WF2  + 5767168;
constexpr size_t OFF_U16  = OFF_ROPE + 2097152;
constexpr size_t OFF_Q    = OFF_U16  + 67108864;
constexpr size_t OFF_KH   = OFF_Q    + 33554432;
constexpr size_t OFF_VH   = OFF_KH   + 33554432;
constexpr size_t OFF_QI   = OFF_VH   + 33554432;
constexpr size_t OFF_KI   = OFF_QI   + 33554432;
constexpr size_t OFF_WI   = OFF_KI   + 4194304;
constexpr size_t OFF_PR   = OFF_WI   + 1048576;
constexpr size_t OFF_YRAW = OFF_PR;
constexpr size_t OFF_YB   = OFF_PR + 67108864;
constexpr size_t OFF_SEL  = OFF_YB + 33554432;
constexpr size_t OFF_LA   = OFF_PR   + 117440512;
constexpr size_t OFF_D    = OFF_LA   + 16777216;
constexpr size_t OFF_VS   = OFF_D    + 67108864;
constexpr size_t OFF_G    = OFF_VS   + 33554432;
constexpr size_t OFF_RK   = OFF_G    + 33554432;
constexpr size_t WS_END   = OFF_RK   + 1048576;

struct Params {
    const float* in[21];
    float* out;
    unsigned char* ws;
    double invf[32];
};
enum { I_X = 0, I_N1G, I_WIN, I_MU, I_WDU, I_W0, I_AUP, I_A0, I_GUP, I_KK, I_KA, I_RK, I_LNG, I_LNB, I_WOR, I_WOA, I_WOUT, I_N2G, I_WF1, I_WF2, I_NFG };

__device__ __forceinline__ float sigm(float x) { return 1.0f / (1.0f + __expf(-x)); }

template <int CTRL> __device__ __forceinline__ float dppf(float x) {
    return __int_as_float(__builtin_amdgcn_update_dpp(0, __float_as_int(x), CTRL, 0xf, 0xf, false));
}
__device__ __forceinline__ float rowsum16(float x) {
    x += dppf<0x128>(x); x += dppf<0x124>(x); x += dppf<0x122>(x); x += dppf<0x121>(x); return x;
}
__device__ __forceinline__ float sum8(float x) {
    x += dppf<0xB1>(x); x += dppf<0x4E>(x); x += dppf<0x141>(x); return x;
}
__device__ __forceinline__ float wave_sum(float x) {
#pragma unroll
    for (int o = 32; o >= 1; o >>= 1) x += __shfl_xor(x, o);
    return x;
}
__device__ __forceinline__ float wave_max(float x) {
#pragma unroll
    for (int o = 32; o >= 1; o >>= 1) x = fmaxf(x, __shfl_xor(x, o));
    return x;
}

__device__ __forceinline__ int colmap(int mode, int n) {
    if (mode == 1) return n < 3912 ? n : -1;
    if (mode == 2) return 3912 + n;
    if (mode == 3) { const int g = n >> 6, r = n & 63; return r < 32 ? g * 32 + r : 2816 + g * 32 + (r - 32); }
    return n;
}
__device__ __forceinline__ void conv_tile(const float* __restrict__ src, int ldsrc, int K, int mode, half_t* __restrict__ dst, int kt, int nt, float* tile) {
    const int tid = threadIdx.x;
    const int nn = tid & 63, kk = tid >> 6;
    const int col = colmap(mode, nt * 64 + nn);
#pragma unroll
    for (int i = 0; i < 8; ++i) {
        const int k = kk + 8 * i;
        tile[k * 65 + nn] = col >= 0 ? src[(size_t)(kt * 64 + k) * ldsrc + col] : 0.f;
    }
    __syncthreads();
#pragma unroll
    for (int i = 0; i < 8; ++i) {
        const int n = kk + 8 * i;
        dst[(size_t)(nt * 64 + n) * K + kt * 64 + nn] = (half_t)tile[nn * 65 + n];
    }
    __syncthreads();
}

__device__ __forceinline__ void sincos_d(double a, float& c, float& s) {
    const double n = rint(a * 0.63661977236758134308);
    double r = fma(-n, 1.57079632679489655800e+00, a);
    r = fma(-n, 6.12323399573676603587e-17, r);
    const double r2 = r * r;
    double sp = -1.0 / 1307674368000.0;
    sp = fma(sp, r2, 1.0 / 6227020800.0);
    sp = fma(sp, r2, -1.0 / 39916800.0);
    sp = fma(sp, r2, 1.0 / 362880.0);
    sp = fma(sp, r2, -1.0 / 5040.0);
    sp = fma(sp, r2, 1.0 / 120.0);
    sp = fma(sp, r2, -1.0 / 6.0);
    const double sn = fma(sp * r2, r, r);
    double cp = 1.0 / 20922789888000.0;
    cp = fma(cp, r2, -1.0 / 87178291200.0);
    cp = fma(cp, r2, 1.0 / 479001600.0);
    cp = fma(cp, r2, -1.0 / 3628800.0);
    cp = fma(cp, r2, 1.0 / 40320.0);
    cp = fma(cp, r2, -1.0 / 720.0);
    cp = fma(cp, r2, 1.0 / 24.0);
    cp = fma(cp, r2, -0.5);
    const double cs = fma(cp, r2, 1.0);
    const int q = ((int)n) & 3;
    double cc = (q & 1) ? sn : cs, ss = (q & 1) ? cs : sn;
    if (q == 1 || q == 2) cc = -cc;
    if (q == 2 || q == 3) ss = -ss;
    c = (float)cc; s = (float)ss;
}

__device__ __forceinline__ void rmsnorm_rows_f16(const float* __restrict__ x, const float* __restrict__ g, half_t* __restrict__ o) {
    const int lane = threadIdx.x & 63, wid = threadIdx.x >> 6;
    for (int row = blockIdx.x * 8 + wid; row < NTOK; row += gridDim.x * 8) {
        const f4* xr = (const f4*)(x + (size_t)row * 1024);
        f4 v[4]; float ss = 0.f;
#pragma unroll
        for (int i = 0; i < 4; ++i) { v[i] = xr[lane + 64 * i]; ss += v[i][0] * v[i][0] + v[i][1] * v[i][1] + v[i][2] * v[i][2] + v[i][3] * v[i][3]; }
        ss = wave_sum(ss);
        const float rs = rsqrtf(ss * (1.0f / 1024.0f) + 1e-6f);
#pragma unroll
        for (int i = 0; i < 4; ++i) {
            const f4 gg = ((const f4*)g)[lane + 64 * i];
            h4 w; w[0] = (half_t)(v[i][0] * rs * gg[0]); w[1] = (half_t)(v[i][1] * rs * gg[1]); w[2] = (half_t)(v[i][2] * rs * gg[2]); w[3] = (half_t)(v[i][3] * rs * gg[3]);
            *(h4*)(o + (size_t)row * 1024 + (lane + 64 * i) * 4) = w;
        }
    }
}

__device__ __forceinline__ void phase_convert(const Params& p, unsigned char* lds) {
    float* tile = (float*)lds;
    unsigned char* ws = p.ws;
    const int total = 1024 + 512 + 8 + 8 + 16 + 128 + 128 + 256 + 1408 + 704;
    for (int t = blockIdx.x; t < total; t += gridDim.x) {
        int j, r;
        if (t < 1024) { j = 0; r = t; } else if (t < 1536) { j = 1; r = t - 1024; } else if (t < 1544) { j = 2; r = t - 1536; } else if (t < 1552) { j = 3; r = t - 1544; }
        else if (t < 1568) { j = 4; r = t - 1552; } else if (t < 1696) { j = 5; r = t - 1568; } else if (t < 1824) { j = 6; r = t - 1696; } else if (t < 2080) { j = 7; r = t - 1824; }
        else if (t < 3488) { j = 8; r = t - 2080; } else { j = 9; r = t - 3488; }
        if (j == 0) conv_tile(p.in[I_WIN], 5960, 1024, 1, (half_t*)(ws + OFF_WIN), r / 64, r % 64, tile);
        else if (j == 1) conv_tile(p.in[I_WIN], 5960, 1024, 2, (half_t*)(ws + OFF_WG), r / 32, r % 32, tile);
        else if (j == 2) conv_tile(p.in[I_WDU], 512, 64, 0, (half_t*)(ws + OFF_WD), r / 8, r % 8, tile);
        else if (j == 3) conv_tile(p.in[I_AUP], 512, 64, 0, (half_t*)(ws + OFF_AUP), r / 8, r % 8, tile);
        else if (j == 4) conv_tile(p.in[I_GUP], 512, 128, 0, (half_t*)(ws + OFF_GUP), r / 8, r % 8, tile);
        else if (j == 5) conv_tile(p.in[I_WOR], 1024, 512, 0, (half_t*)(ws + OFF_WOR), r / 16, r % 16, tile);
        else if (j == 6) conv_tile(p.in[I_WOA], 1024, 512, 0, (half_t*)(ws + OFF_WOA), r / 16, r % 16, tile);
        else if (j == 7) conv_tile(p.in[I_WOUT], 1024, 1024, 0, (half_t*)(ws + OFF_WOUT), r / 16, r % 16, tile);
        else if (j == 8) conv_tile(p.in[I_WF1], 5632, 1024, 3, (half_t*)(ws + OFF_WF1), r / 88, r % 88, tile);
        else conv_tile(p.in[I_WF2], 1024, 2816, 0, (half_t*)(ws + OFF_WF2), r / 16, r % 16, tile);
    }
    float2* rope = (float2*)(ws + OFF_ROPE);
    for (int i = blockIdx.x * NTHREADS + threadIdx.x; i < SEQ * 32; i += gridDim.x * NTHREADS) {
        const int pos = i >> 5, j = i & 31;
        float c, s; sincos_d((double)pos * p.invf[j], c, s);
        rope[i] = make_float2(c, s);
    }
    rmsnorm_rows_f16(p.in[I_X], p.in[I_N1G], (half_t*)(ws + OFF_U16));
}

__device__ __forceinline__ u32x4 gload_asm(const void* p) {
    u32x4 r;
    asm volatile("global_load_dwordx4 %0, %1, off" : "=&v"(r) : "v"(p) : "memory");
    return r;
}
__device__ __forceinline__ u32x4 gload_asm_s(const void* sbase, unsigned voff) {
    u32x4 r;
    asm volatile("global_load_dwordx4 %0, %1, %2" : "=&v"(r) : "v"(voff), "s"(sbase) : "memory");
    return r;
}
template <int NJ>
__device__ __forceinline__ void gemm_main(f16v (&acc)[2][NJ], const half_t* __restrict__ A, int lda, const half_t* __restrict__ Bt, int ldb, int K, int m0, int n0, unsigned char* lds) {
    const int tid = threadIdx.x, lane = tid & 63, wid = tid >> 6, wm = wid >> 1, wn = wid & 1;
    constexpr int NB = NJ;
    constexpr int STAGE = 32768 + 64 * NJ * 128;
#pragma unroll
    for (int mi = 0; mi < 2; ++mi)
#pragma unroll
        for (int nj = 0; nj < NJ; ++nj)
#pragma unroll
            for (int e = 0; e < 16; ++e) acc[mi][nj][e] = 0.f;
    const int srow = tid >> 3, sch = tid & 7;
    const int swz_w = (sch ^ ((srow >> 1) & 7)) << 4;
    const half_t* Ag = A + (size_t)(m0 + srow) * lda + sch * 8;
    const half_t* Bg = Bt + (size_t)(n0 + srow) * ldb + sch * 8;
    u32x4 ra[4], rb[NB];
    const int nk = K >> 6;
#pragma unroll
    for (int i = 0; i < 4; ++i) ra[i] = *(const u32x4*)(Ag + (size_t)i * 64 * lda);
#pragma unroll
    for (int i = 0; i < NB; ++i) rb[i] = *(const u32x4*)(Bg + (size_t)i * 64 * ldb);
    __syncthreads();
#pragma unroll
    for (int i = 0; i < 4; ++i) *(u32x4*)(lds + (srow + 64 * i) * 128 + swz_w) = ra[i];
#pragma unroll
    for (int i = 0; i < NB; ++i) *(u32x4*)(lds + 32768 + (srow + 64 * i) * 128 + swz_w) = rb[i];
    {
        const int k0 = (nk > 1 ? 1 : 0) * 64;
#pragma unroll
        for (int i = 0; i < 4; ++i) ra[i] = *(const u32x4*)(Ag + (size_t)i * 64 * lda + k0);
#pragma unroll
        for (int i = 0; i < NB; ++i) rb[i] = *(const u32x4*)(Bg + (size_t)i * 64 * ldb + k0);
    }
    const int r31 = lane & 31, hh = lane >> 5;
    const int swz_r = (r31 >> 1) & 7;
    for (int kt = 0; kt < nk; ++kt) {
        __syncthreads();
        {
            unsigned char* nb = lds + ((kt + 1) & 1) * STAGE;
#pragma unroll
            for (int i = 0; i < 4; ++i) *(u32x4*)(nb + (srow + 64 * i) * 128 + swz_w) = ra[i];
#pragma unroll
            for (int i = 0; i < NB; ++i) *(u32x4*)(nb + 32768 + (srow + 64 * i) * 128 + swz_w) = rb[i];
            const int k0 = (kt + 2 < nk ? kt + 2 : nk - 1) * 64;
#pragma unroll
            for (int i = 0; i < 4; ++i) ra[i] = *(const u32x4*)(Ag + (size_t)i * 64 * lda + k0);
#pragma unroll
            for (int i = 0; i < NB; ++i) rb[i] = *(const u32x4*)(Bg + (size_t)i * 64 * ldb + k0);
            __builtin_amdgcn_sched_barrier(0);
        }
        const unsigned char* base = lds + (kt & 1) * STAGE;
        const unsigned char* aB = base + (wm * 64 + r31) * 128;
        const unsigned char* bB = base + 32768 + (wn * 32 * NJ + r31) * 128;
#pragma unroll
        for (int ks = 0; ks < 4; ++ks) {
            const int co = ((ks * 2 + hh) ^ swz_r) << 4;
            h8 af[2], bf[NJ];
#pragma unroll
            for (int mi = 0; mi < 2; ++mi) af[mi] = *(const h8*)(aB + mi * 32 * 128 + co);
#pragma unroll
            for (int nj = 0; nj < NJ; ++nj) bf[nj] = *(const h8*)(bB + nj * 32 * 128 + co);
#pragma unroll
            for (int mi = 0; mi < 2; ++mi)
#pragma unroll
                for (int nj = 0; nj < NJ; ++nj) acc[mi][nj] = __builtin_amdgcn_mfma_f32_32x32x16_f16(bf[nj], af[mi], acc[mi][nj], 0, 0, 0);
        }
    }
    asm volatile("s_waitcnt vmcnt(0)" ::: "memory");
}

#define XCD_TILE_LOOP(NTn) for (int L_ = (int)blockIdx.x >> 3; L_ < 16 * (NTn); L_ += (int)gridDim.x >> 3)
__device__ __forceinline__ void xcd_tile(int L, int NTn, int& mt, int& nt) {
    const int per = 8 * NTn, mh = L / per, rem = L - mh * per;
    nt = rem >> 3; mt = ((int)blockIdx.x & 7) * 16 + mh * 8 + (rem & 7);
}
__device__ __forceinline__ h4 pack4(float a, float b, float c, float d) { h4 w; w[0] = (half_t)a; w[1] = (half_t)b; w[2] = (half_t)c; w[3] = (half_t)d; return w; }

__device__ __forceinline__ void epi_inproj(const Params& p, f16v (&acc)[2][4], int m0, int n0) {
    const int tid = threadIdx.x, lane = tid & 63, wid = tid >> 6, wm = wid >> 1, wn = wid & 1, r31 = lane & 31, hh = lane >> 5;
    const int nb = n0 + wn * 128;
    if (nb >= 3968) return;
    unsigned char* ws = p.ws;
    const float2* rope = (const float2*)(ws + OFF_ROPE);
#pragma unroll
    for (int mi = 0; mi < 2; ++mi) {
        const int m = m0 + wm * 64 + mi * 32 + r31, pos = m & (SEQ - 1), b = m >> 13;
        if (nb < 1792) {
            half_t* dst = (half_t*)(ws + OFF_PR) + (size_t)m * 1792 + nb + hh * 4;
#pragma unroll
            for (int nj = 0; nj < 4; ++nj)
#pragma unroll
                for (int rg = 0; rg < 4; ++rg)
                    *(h4*)(dst + nj * 32 + rg * 8) = pack4(acc[mi][nj][rg * 4], acc[mi][nj][rg * 4 + 1], acc[mi][nj][rg * 4 + 2], acc[mi][nj][rg * 4 + 3]);
        } else {
#pragma unroll
            for (int hd = 0; hd < 2; ++hd) {
                const int nh = nb + hd * 64;
                half_t* dst; bool dorope = true, kifrag = false; float sc = 1.0f;
                if (nh < 2304) { dst = (half_t*)(ws + OFF_Q) + (size_t)m * 512 + (nh - 1792); sc = 0.125f; }
                else if (nh < 2816) { dst = (half_t*)(ws + OFF_KH) + ((size_t)(b * 8 + ((nh - 2304) >> 6)) * SEQ + pos) * 64; }
                else if (nh < 3328) { dst = (half_t*)(ws + OFF_VH) + ((size_t)(b * 8 + ((nh - 2816) >> 6)) * SEQ + pos) * 64; dorope = false; }
                else if (nh < 3840) { dst = (half_t*)(ws + OFF_QI) + (size_t)m * 512 + (nh - 3328); }
                else if (nh == 3840) { dst = (half_t*)(ws + OFF_KI); kifrag = true; }
                else {
                    if (hd == 1) {
                        f4 w;
                        w[0] = acc[mi][2][0] * 0.044194173824159216f; w[1] = acc[mi][2][1] * 0.044194173824159216f;
                        w[2] = acc[mi][2][2] * 0.044194173824159216f; w[3] = acc[mi][2][3] * 0.044194173824159216f;
                        *(f4*)((float*)(ws + OFF_WI) + (size_t)m * 8 + hh * 4) = w;
                    }
                    continue;
                }
#pragma unroll
                for (int rg = 0; rg < 4; ++rg) {
                    const int d = rg * 8 + hh * 4;
                    float o1[4], o2[4];
                    if (dorope) {
                        const f4 cs0 = *(const f4*)(rope + pos * 32 + d), cs1 = *(const f4*)(rope + pos * 32 + d + 2);
                        const float c[4] = {cs0[0], cs0[2], cs1[0], cs1[2]}, s[4] = {cs0[1], cs0[3], cs1[1], cs1[3]};
#pragma unroll
                        for (int e = 0; e < 4; ++e) {
                            const float x1 = acc[mi][2 * hd][rg * 4 + e], x2 = acc[mi][2 * hd + 1][rg * 4 + e];
                            o1[e] = (x1 * c[e] - x2 * s[e]) * sc; o2[e] = (x1 * s[e] + x2 * c[e]) * sc;
                        }
                    } else {
#pragma unroll
                        for (int e = 0; e < 4; ++e) { o1[e] = acc[mi][2 * hd][rg * 4 + e]; o2[e] = acc[mi][2 * hd + 1][rg * 4 + e]; }
                    }
                    if (kifrag) {
                        const size_t cb = (size_t)(m >> 5) * 4, rr = (size_t)(m & 31);
                        const int da = d, db = d + 32;
                        *(h4*)(dst + (((cb + (da >> 4)) * 64 + ((da >> 3) & 1) * 32 + rr) * 8 + (da & 7))) = pack4(o1[0], o1[1], o1[2], o1[3]);
                        *(h4*)(dst + (((cb + (db >> 4)) * 64 + ((db >> 3) & 1) * 32 + rr) * 8 + (db & 7))) = pack4(o2[0], o2[1], o2[2], o2[3]);
                    } else {
                        *(h4*)(dst + d) = pack4(o1[0], o1[1], o1[2], o1[3]);
                        *(h4*)(dst + d + 32) = pack4(o2[0], o2[1], o2[2], o2[3]);
                    }
                }
            }
        }
    }
}

__device__ __forceinline__ void phase_inproj(const Params& p, unsigned char* lds) {
    const half_t* A = (const half_t*)(p.ws + OFF_U16);
    const half_t* Bt = (const half_t*)(p.ws + OFF_WIN);
    XCD_TILE_LOOP(16) {
        int mt, nt; xcd_tile(L_, 16, mt, nt);
        f16v acc[2][4];
        gemm_main<4>(acc, A, 1024, Bt, 1024, 1024, mt * 256, nt * 256, lds);
        epi_inproj(p, acc, mt * 256, nt * 256);
    }
}

__device__ __forceinline__ void phase_prep(const Params& p) {
    const half_t* PR = (const half_t*)(p.ws + OFF_PR);
    half_t* LA = (half_t*)(p.ws + OFF_LA);
    const float* mu = p.in[I_MU];
    for (int i = blockIdx.x * NTHREADS + threadIdx.x; i < NTOK * 32; i += gridDim.x * NTHREADS) {
        const int m = i >> 5, c8 = (i & 31) * 8, pos = m & (SEQ - 1);
        const h8 cur = *(const h8*)(PR + (size_t)m * 1792 + 1536 + c8);
        h8 prv;
        if (pos > 0) prv = *(const h8*)(PR + (size_t)(m - 1) * 1792 + 1536 + c8);
        else {
#pragma unroll
            for (int e = 0; e < 8; ++e) prv[e] = (half_t)0.f;
        }
        h8 o;
#pragma unroll
        for (int e = 0; e < 8; ++e) {
            const float x = (float)cur[e], xp = (float)prv[e];
            const float s = x + (xp - x) * mu[1536 + c8 + e];
            float r;
            if (c8 < 64) r = tanhf(s); else if (c8 < 128) r = s; else r = sigm(s);
            o[e] = (half_t)r;
        }
        *(h8*)(LA + (size_t)m * 256 + c8) = o;
    }
}

__device__ __forceinline__ void ld_shift4(const half_t* cur, const half_t* prv, bool hasprev, const float* mu, float (&o)[4]) {
    const h4 a = *(const h4*)cur;
    h4 b;
    if (hasprev) b = *(const h4*)prv; else { b[0] = (half_t)0.f; b[1] = (half_t)0.f; b[2] = (half_t)0.f; b[3] = (half_t)0.f; }
    const f4 m4 = *(const f4*)mu;
#pragma unroll
    for (int e = 0; e < 4; ++e) { const float x = (float)a[e], xp = (float)b[e]; o[e] = x + (xp - x) * m4[e]; }
}

__device__ __forceinline__ void phase_lora(const Params& p, unsigned char* lds) {
    unsigned char* ws = p.ws;
    const half_t* LA = (const half_t*)(ws + OFF_LA);
    const half_t* PR = (const half_t*)(ws + OFF_PR);
    const int tid = threadIdx.x, lane = tid & 63, wid = tid >> 6, wm = wid >> 1, wn = wid & 1, r31 = lane & 31, hh = lane >> 5;
    if (LORA_PARTS & 1) for (int t = blockIdx.x; t < 128 * 2; t += gridDim.x) {
        const int mt = t >> 1, nt = t & 1, m0 = mt * 256, n0 = nt * 256, nb = n0 + wn * 128;
        f16v acc[2][4];
        gemm_main<4>(acc, LA, 256, (const half_t*)(ws + OFF_WD), 64, 64, m0, n0, lds);
        const float* w0 = p.in[I_W0];
#pragma unroll
        for (int mi = 0; mi < 2; ++mi) {
            const int m = m0 + wm * 64 + mi * 32 + r31, pos = m & (SEQ - 1), b = m >> 13;
#pragma unroll
            for (int nj = 0; nj < 4; ++nj)
#pragma unroll
                for (int rg = 0; rg < 4; ++rg) {
                    const int n = nb + nj * 32 + rg * 8 + hh * 4, h = n >> 6, j = n & 63;
                    const f4 w04 = *(const f4*)(w0 + n);
                    f4 dv;
#pragma unroll
                    for (int e = 0; e < 4; ++e) {
                        const float z = w04[e] + acc[mi][nj][rg * 4 + e];
                        dv[e] = __expf(-0.60653065971263342f / (1.0f + __expf(-z)));
                    }
                    *(f4*)((float*)(ws + OFF_D) + ((size_t)(b * 8 + h) * SEQ + pos) * 64 + j) = dv;
                }
        }
    }
    if (LORA_PARTS & 2) for (int t = blockIdx.x; t < 128 * 2; t += gridDim.x) {
        const int mt = t >> 1, nt = t & 1, m0 = mt * 256, n0 = nt * 256, nb = n0 + wn * 128;
        f16v acc[2][4];
        gemm_main<4>(acc, LA + 128, 256, (const half_t*)(ws + OFF_GUP), 128, 128, m0, n0, lds);
#pragma unroll
        for (int mi = 0; mi < 2; ++mi) {
            const int m = m0 + wm * 64 + mi * 32 + r31;
            half_t* G = (half_t*)(ws + OFF_G) + (size_t)m * 512 + nb + hh * 4;
#pragma unroll
            for (int nj = 0; nj < 4; ++nj)
#pragma unroll
                for (int rg = 0; rg < 4; ++rg)
                    *(h4*)(G + nj * 32 + rg * 8) = pack4(acc[mi][nj][rg * 4], acc[mi][nj][rg * 4 + 1], acc[mi][nj][rg * 4 + 2], acc[mi][nj][rg * 4 + 3]);
        }
    }
    if (LORA_PARTS & 4) for (int t = blockIdx.x; t < 128 * 4; t += gridDim.x) {
        const int mt = t >> 2, nt = t & 3, m0 = mt * 256, n0 = nt * 128;
        f16v acc[2][2];
        gemm_main<2>(acc, LA + 64, 256, (const half_t*)(ws + OFF_AUP), 64, 64, m0, n0, lds);
        const float* mu = p.in[I_MU]; const float* a0 = p.in[I_A0]; const float* kkw = p.in[I_KK]; const float* kaw = p.in[I_KA]; const float* rkw = p.in[I_RK];
        {
            const int h = (n0 >> 6) + wn;
#pragma unroll
            for (int mi = 0; mi < 2; ++mi) {
                const int m = m0 + wm * 64 + mi * 32 + r31, pos = m & (SEQ - 1), b = m >> 13;
                unsigned char* rec = (unsigned char*)p.out + ((size_t)(b * 8 + h) * SEQ + pos) * 512;
#pragma unroll
                for (int blk = 0; blk < 2; ++blk)
#pragma unroll
                    for (int rg = 0; rg < 4; ++rg) {
                        const int j = blk * 32 + rg * 8 + hh * 4, n = h * 64 + j;
                        const f4 a04 = *(const f4*)(a0 + n);
                        f4 av;
#pragma unroll
                        for (int e = 0; e < 4; ++e) av[e] = sigm(a04[e] + acc[mi][blk][rg * 4 + e]);
                        *(f4*)(rec + (j >> 2) * 32 + 16) = av;
                    }
            }
        }
        __threadfence_block();
        __syncthreads();
#pragma unroll 2
        for (int it = 0; it < 16; ++it) {
            const int idx = it * NTHREADS + tid, pair = idx >> 4, jg = idx & 15;
            const int m = m0 + (pair >> 1), h = (n0 >> 6) + (pair & 1), pos = m & (SEQ - 1), b = m >> 13, n = h * 64 + 4 * jg;
            const half_t* prow = PR + (size_t)m * 1792; const half_t* pprev = prow - 1792; const bool hp = pos > 0;
            float rs[4], ks[4], vs[4];
            ld_shift4(prow + n, pprev + n, hp, mu + n, rs);
            ld_shift4(prow + 512 + n, pprev + 512 + n, hp, mu + 512 + n, ks);
            ld_shift4(prow + 1024 + n, pprev + 1024 + n, hp, mu + 1024 + n, vs);
            unsigned char* rec = (unsigned char*)p.out + ((size_t)(b * 8 + h) * SEQ + pos) * 512 + jg * 32;
            const f4 av = *(const f4*)(rec + 16);
            const f4 kk4 = *(const f4*)(kkw + n), ka4 = *(const f4*)(kaw + n), rk4 = *(const f4*)(rkw + n);
            float kkr[4], kp[4], ss = 0.f, rka = 0.f;
#pragma unroll
            for (int e = 0; e < 4; ++e) {
                kkr[e] = ks[e] * kk4[e]; ss += kkr[e] * kkr[e];
                kp[e] = ks[e] * (1.0f + (av[e] - 1.0f) * ka4[e]);
                rka += rs[e] * kp[e] * rk4[e];
            }
            ss = rowsum16(ss); rka = rowsum16(rka);
            const float inv = 1.0f / fmaxf(sqrtf(ss), 1e-12f);
            h8 w0v, w1v;
#pragma unroll
            for (int e = 0; e < 4; ++e) {
                const float kk = kkr[e] * inv;
                w0v[e] = (half_t)rs[e]; w0v[4 + e] = (half_t)kp[e];
                w1v[e] = (half_t)kk; w1v[4 + e] = (half_t)(kk * av[e]);
            }
            *(h8*)rec = w0v;
            *(h8*)(rec + 16) = w1v;
            *(h4*)((half_t*)(ws + OFF_VS) + (size_t)m * 512 + n) = pack4(vs[0], vs[1], vs[2], vs[3]);
            if (jg == 0) ((float*)(ws + OFF_RK))[(size_t)m * 8 + h] = rka;
        }
    }
}

struct ScanIn { f4 d; u32x4 h0, h1; h2 v; };
__device__ __forceinline__ void phase_scan(const Params& p) {
    const int lane = threadIdx.x & 63, wid = threadIdx.x >> 6;
    const int jg = lane & 15, sub = lane >> 4;
    if (wid >= 4) return;
    {
        const int xj = (int)blockIdx.x >> 3;
        const int bh = ((int)blockIdx.x & 7) + 8 * (xj >> 1), rgp = (xj & 1) * 4 + wid, b = bh >> 3, h = bh & 7, i = rgp * 8 + sub * 2;
        const f4* Dp = (const f4*)(p.ws + OFF_D) + (size_t)bh * SEQ * 16 + jg;
        const u32x4* Hp = (const u32x4*)p.out + (size_t)bh * SEQ * 32 + jg * 2;
        const half_t* Vp = (const half_t*)(p.ws + OFF_VS) + (size_t)b * SEQ * 512 + h * 64 + i;
        float* Yp = (float*)(p.ws + OFF_YRAW) + (size_t)b * SEQ * 512 + h * 64 + i;
        float a0 = 0.f, a1 = 0.f, a2 = 0.f, a3 = 0.f, b0 = 0.f, b1 = 0.f, b2 = 0.f, b3 = 0.f;
        ScanIn A[4], Bf[4], C[4];
#define SCAN_LOAD(buf, tb) { _Pragma("unroll") for (int q = 0; q < 4; ++q) { int tt = (tb) + q; tt = tt < SEQ ? tt : SEQ - 1; \
            buf[q].d = Dp[(size_t)tt * 16]; buf[q].h0 = Hp[(size_t)tt * 32]; buf[q].h1 = Hp[(size_t)tt * 32 + 1]; buf[q].v = *(const h2*)(Vp + (size_t)tt * 512); } }
#define SCAN_STEP(buf, tb) { float ya[4], yb[4]; _Pragma("unroll") for (int q = 0; q < 4; ++q) { \
            const h8 x0 = *(const h8*)&buf[q].h0, x1 = *(const h8*)&buf[q].h1; const f4 d = buf[q].d; \
            const float va = (float)buf[q].v[0], vb = (float)buf[q].v[1]; \
            const float k0 = (float)x1[0], k1 = (float)x1[1], k2 = (float)x1[2], k3 = (float)x1[3]; \
            const float g0 = (float)x1[4], g1 = (float)x1[5], g2 = (float)x1[6], g3 = (float)x1[7]; \
            const float r0 = (float)x0[0], r1 = (float)x0[1], r2 = (float)x0[2], r3 = (float)x0[3]; \
            const float p0 = (float)x0[4], p1 = (float)x0[5], p2 = (float)x0[6], p3 = (float)x0[7]; \
            float sa = (a0 * k0 + a1 * k1) + (a2 * k2 + a3 * k3), sb = (b0 * k0 + b1 * k1) + (b2 * k2 + b3 * k3); \
            sa += dppf<0x128>(sa); sb += dppf<0x128>(sb); sa += dppf<0x124>(sa); sb += dppf<0x124>(sb); \
            sa += dppf<0x122>(sa); sb += dppf<0x122>(sb); sa += dppf<0x121>(sa); sb += dppf<0x121>(sb); \
            a0 = (a0 * d[0] + va * p0) - sa * g0; a1 = (a1 * d[1] + va * p1) - sa * g1; a2 = (a2 * d[2] + va * p2) - sa * g2; a3 = (a3 * d[3] + va * p3) - sa * g3; \
            b0 = (b0 * d[0] + vb * p0) - sb * g0; b1 = (b1 * d[1] + vb * p1) - sb * g1; b2 = (b2 * d[2] + vb * p2) - sb * g2; b3 = (b3 * d[3] + vb * p3) - sb * g3; \
            float y1 = (a0 * r0 + a1 * r1) + (a2 * r2 + a3 * r3), y2 = (b0 * r0 + b1 * r1) + (b2 * r2 + b3 * r3); \
            y1 += dppf<0x128>(y1); y2 += dppf<0x128>(y2); y1 += dppf<0x124>(y1); y2 += dppf<0x124>(y2); \
            y1 += dppf<0x122>(y1); y2 += dppf<0x122>(y2); y1 += dppf<0x121>(y1); y2 += dppf<0x121>(y2); \
            ya[q] = y1; yb[q] = y2; } \
            if (jg == 0) { _Pragma("unroll") for (int q = 0; q < 4; ++q) if ((tb) + q < SEQ) *(float2*)(Yp + (size_t)((tb) + q) * 512) = make_float2(ya[q], yb[q]); } }
#define SCAN_LOADF(buf, tb) { const f4* dq_ = Dp + (size_t)(tb) * 16; const u32x4* hq_ = Hp + (size_t)(tb) * 32; const half_t* vq_ = Vp + (size_t)(tb) * 512; \
            _Pragma("unroll") for (int q = 0; q < 4; ++q) { buf[q].d = dq_[q * 16]; buf[q].h0 = hq_[q * 32]; buf[q].h1 = hq_[q * 32 + 1]; buf[q].v = *(const h2*)(vq_ + q * 512); } }
        SCAN_LOAD(A, 0); SCAN_LOAD(Bf, 4);
        int t0 = 0;
        for (; t0 + 24 <= SEQ; t0 += 12) {
            SCAN_LOADF(C, t0 + 8);
            SCAN_STEP(A, t0);
            SCAN_LOADF(A, t0 + 12);
            SCAN_STEP(Bf, t0 + 4);
            SCAN_LOADF(Bf, t0 + 16);
            SCAN_STEP(C, t0 + 8);
        }
        for (; t0 < SEQ; t0 += 12) {
            SCAN_LOAD(C, t0 + 8);
            SCAN_STEP(A, t0);
            SCAN_LOAD(A, t0 + 12);
            SCAN_STEP(Bf, t0 + 4);
            SCAN_LOAD(Bf, t0 + 16);
            SCAN_STEP(C, t0 + 8);
        }
#undef SCAN_LOADF
#undef SCAN_LOAD
#undef SCAN_STEP
    }
}

__device__ __forceinline__ unsigned fkey(float f) { const unsigned u = __float_as_uint(f); return (u & 0x80000000u) ? ~u : (u | 0x80000000u); }

#define HSTRIDE 2112
__device__ __forceinline__ void phase_indexer(const Params& p, unsigned char* lds, int blk0, int nblk) {
    unsigned* S = (unsigned*)lds;
    unsigned* hist = (unsigned*)(lds + 131072);
    int* misc = (int*)(lds + 131072 + 2 * HSTRIDE * 4);
    unsigned char* ws = p.ws;
    const half_t* QI = (const half_t*)(ws + OFF_QI);
    const half_t* KI = (const half_t*)(ws + OFF_KI);
    const float* WI = (const float*)(ws + OFF_WI);
    u16* SEL = (u16*)(ws + OFF_SEL);
    const int tid = threadIdx.x, lane = tid & 63, wid = tid >> 6, r31 = lane & 31, hh = lane >> 5;
    const int bx = (int)blockIdx.x - blk0;
    if (bx < 0 || bx >= nblk) return;
    const int hr = (r31 >> 2) & 1, ir = (r31 & 3) + 4 * (r31 >> 3), qr = 2 * hr + (ir >> 3), hdr = ir & 7;
    h8 afn[4]; f4 wn0, wn1, wn2, wn3;
#define IDX_FETCH(task_) { const int tk_ = (task_) < 8192 ? (task_) : bx; const int r0_ = (tk_ & 3) * SEQ + (tk_ >> 2) * 4; \
        const half_t* qp_ = QI + (size_t)(r0_ + qr) * 512 + hdr * 64 + 8 * hh; \
        _Pragma("unroll") for (int ks = 0; ks < 4; ++ks) afn[ks] = *(const h8*)(qp_ + ks * 16); \
        wn0 = *(const f4*)(WI + (size_t)(r0_ + 2 * hh) * 8); wn1 = *(const f4*)(WI + (size_t)(r0_ + 2 * hh) * 8 + 4); \
        wn2 = *(const f4*)(WI + (size_t)(r0_ + 2 * hh + 1) * 8); wn3 = *(const f4*)(WI + (size_t)(r0_ + 2 * hh + 1) * 8 + 4); }
    IDX_FETCH(bx)
    for (int task = bx; task < 8192; task += nblk) {
        const int b = task & 3, t0 = (task >> 2) * 4, row0 = b * SEQ + t0;
        u16* sel = SEL + (size_t)row0 * 256;
        h8 af[4];
#pragma unroll
        for (int ks = 0; ks < 4; ++ks) af[ks] = afn[ks];
        const f4 wa0 = wn0, wa1 = wn1, wb0 = wn2, wb1 = wn3;
        if (t0 < 256) {
            for (int idx = tid; idx < 1024; idx += NTHREADS) { const int q = idx >> 8, j = idx & 255; sel[idx] = (j <= t0 + q) ? (u16)j : (u16)0xFFFF; }
            IDX_FETCH(task + nblk)
            continue;
        }
        const int nc = (t0 + 4 + 31) >> 5, nn = nc * 32;
        const int ta = t0 + 2 * hh, tb = ta + 1;
        const half_t* kbase = KI + (size_t)b * SEQ * 64 + (size_t)lane * 8;
        {
            h8 bA[4][4], bB[4][4];
#define SC_LOAD(buf, cs) { _Pragma("unroll") for (int u = 0; u < 4; ++u) { int c = (cs) + 8 * u; c = c < nc ? c : nc - 1; const half_t* kp = kbase + (size_t)c * 2048; \
                _Pragma("unroll") for (int ks = 0; ks < 4; ++ks) buf[u][ks] = *(const h8*)(kp + ks * 512); } }
#define SC_PROC(buf, cs) { _Pragma("unroll") for (int u = 0; u < 4; ++u) { const int c = (cs) + 8 * u; if (c < nc) { const int s = c * 32 + r31; \
                f16v acc; _Pragma("unroll") for (int e = 0; e < 16; ++e) acc[e] = 0.f; \
                _Pragma("unroll") for (int ks = 0; ks < 4; ++ks) acc = __builtin_amdgcn_mfma_f32_32x32x16_f16(af[ks], buf[u][ks], acc, 0, 0, 0); \
                float sa0 = 0.f, sa1 = 0.f, sb0 = 0.f, sb1 = 0.f; \
                _Pragma("unroll") for (int e = 0; e < 4; ++e) { sa0 += wa0[e] * fmaxf(acc[e], 0.f); sa1 += wa1[e] * fmaxf(acc[4 + e], 0.f); sb0 += wb0[e] * fmaxf(acc[8 + e], 0.f); sb1 += wb1[e] * fmaxf(acc[12 + e], 0.f); } \
                S[(2 * hh) * 8192 + s] = (s <= ta) ? fkey(sa0 + sa1) : 0u; S[(2 * hh + 1) * 8192 + s] = (s <= tb) ? fkey(sb0 + sb1) : 0u; } } }
            SC_LOAD(bA, wid)
            for (int c0 = wid; c0 < nc; c0 += 64) {
                SC_LOAD(bB, c0 + 32)
                SC_PROC(bA, c0)
                SC_LOAD(bA, c0 + 64)
                SC_PROC(bB, c0 + 32)
            }
#undef SC_LOAD
#undef SC_PROC
        }
        IDX_FETCH(task + nblk)
        __syncthreads();
        unsigned T0 = 0, T1 = 0, T2 = 0, T3 = 0, pmask = 0; int k0 = 256, k1 = 256, k2 = 256, k3 = 256;
#pragma unroll 1
        for (int pass = 0; pass < 3; ++pass) {
            const int shift = pass == 0 ? 21 : (pass == 1 ? 10 : 0);
            const unsigned dmask = pass == 2 ? 1023u : 2047u;
            for (int i = tid; i < 2 * HSTRIDE; i += NTHREADS) hist[i] = 0u;
            __syncthreads();
            for (int s = tid; s < nn; s += NTHREADS) {
                const unsigned key0 = S[s], key1 = S[8192 + s], key2 = S[16384 + s], key3 = S[24576 + s];
                if ((key0 & pmask) == T0) { const unsigned bin = (key0 >> shift) & dmask; atomicAdd(&hist[bin + (bin >> 5)], 1u); }
                if ((key1 & pmask) == T1) { const unsigned bin = (key1 >> shift) & dmask; atomicAdd(&hist[bin + (bin >> 5)], 65536u); }
                if ((key2 & pmask) == T2) { const unsigned bin = (key2 >> shift) & dmask; atomicAdd(&hist[HSTRIDE + bin + (bin >> 5)], 1u); }
                if ((key3 & pmask) == T3) { const unsigned bin = (key3 >> shift) & dmask; atomicAdd(&hist[HSTRIDE + bin + (bin >> 5)], 65536u); }
            }
            __syncthreads();
            if (wid < 4) {
                const unsigned* hb = hist + (wid >> 1) * HSTRIDE + 33 * lane;
                const int sh = (wid & 1) * 16;
                const int kl = wid == 0 ? k0 : (wid == 1 ? k1 : (wid == 2 ? k2 : k3));
                int tot = 0;
#pragma unroll 8
                for (int i = 0; i < 32; ++i) tot += (int)((hb[i] >> sh) & 0xFFFFu);
                int v = tot;
#pragma unroll
                for (int off = 1; off < 64; off <<= 1) { const int o = __shfl_down(v, off); if (lane + off < 64) v += o; }
                const int sufx = v - tot;
                const unsigned long long fb = __ballot(sufx < kl && kl <= sufx + tot);
                const int L = (int)__builtin_ctzll(fb);
                const int kk = kl - __builtin_amdgcn_readlane(sufx, L);
                const unsigned cw = lane < 32 ? hist[(wid >> 1) * HSTRIDE + 33 * L + lane] : 0u;
                const int c = (int)((cw >> sh) & 0xFFFFu);
                int ci = c;
#pragma unroll
                for (int off = 1; off < 64; off <<= 1) { const int o = __shfl_down(ci, off); if (lane + off < 64) ci += o; }
                const int cx = ci - c;
                if (cx < kk && kk <= cx + c) { misc[2 * wid] = 32 * L + lane; misc[2 * wid + 1] = kk - cx; misc[8 + wid] = (c == kk - cx) ? 1 : 0; }
            }
            __syncthreads();
            T0 |= (unsigned)misc[0] << shift; k0 = misc[1];
            T1 |= (unsigned)misc[2] << shift; k1 = misc[3];
            T2 |= (unsigned)misc[4] << shift; k2 = misc[5];
            T3 |= (unsigned)misc[6] << shift; k3 = misc[7];
            pmask |= dmask << shift;
            if (pass == 1 && (misc[8] & misc[9] & misc[10] & misc[11])) break;
        }
        const int cl = (((nn + 7) >> 3) + 63) & ~63;
        const int slo = wid * cl, shi = min(nn, slo + cl);
        int* cnt = misc + 32;
        {
            int cg0 = 0, cg1 = 0, cg2 = 0, cg3 = 0, ce0 = 0, ce1 = 0, ce2 = 0, ce3 = 0;
            for (int sb0 = slo; sb0 < shi; sb0 += 64) {
                const int s = sb0 + lane; const bool in = s < shi;
                const unsigned x0 = in ? (S[s] & pmask) : 0u, x1 = in ? (S[8192 + s] & pmask) : 0u, x2 = in ? (S[16384 + s] & pmask) : 0u, x3 = in ? (S[24576 + s] & pmask) : 0u;
                cg0 += __popcll(__ballot(x0 > T0)); ce0 += __popcll(__ballot(x0 == T0));
                cg1 += __popcll(__ballot(x1 > T1)); ce1 += __popcll(__ballot(x1 == T1));
                cg2 += __popcll(__ballot(x2 > T2)); ce2 += __popcll(__ballot(x2 == T2));
                cg3 += __popcll(__ballot(x3 > T3)); ce3 += __popcll(__ballot(x3 == T3));
            }
            if (lane == 0) {
                cnt[(0 * 8 + wid) * 2] = cg0; cnt[(0 * 8 + wid) * 2 + 1] = ce0; cnt[(1 * 8 + wid) * 2] = cg1; cnt[(1 * 8 + wid) * 2 + 1] = ce1;
                cnt[(2 * 8 + wid) * 2] = cg2; cnt[(2 * 8 + wid) * 2 + 1] = ce2; cnt[(3 * 8 + wid) * 2] = cg3; cnt[(3 * 8 + wid) * 2 + 1] = ce3;
            }
        }
        __syncthreads();
        {
            const unsigned long long ltmask = (1ull << lane) - 1ull;
            int og0 = 0, og1 = 0, og2 = 0, og3 = 0, oe0 = 0, oe1 = 0, oe2 = 0, oe3 = 0;
#pragma unroll
            for (int w = 0; w < 8; ++w) if (w < wid) {
                og0 += cnt[(0 * 8 + w) * 2]; oe0 += cnt[(0 * 8 + w) * 2 + 1]; og1 += cnt[(1 * 8 + w) * 2]; oe1 += cnt[(1 * 8 + w) * 2 + 1];
                og2 += cnt[(2 * 8 + w) * 2]; oe2 += cnt[(2 * 8 + w) * 2 + 1]; og3 += cnt[(3 * 8 + w) * 2]; oe3 += cnt[(3 * 8 + w) * 2 + 1];
            }
#define WR1(q, xq, Tq, kq, og, oe) { const bool gt = xq > Tq, eq = xq == Tq; const unsigned long long bg = __ballot(gt), be = __ballot(eq); u16* so = sel + q * 256; \
                if (gt) { const int pos = og + __popcll(bg & ltmask); if (pos < 256) so[pos] = (u16)s; } \
                if (eq) { const int rk = oe + __popcll(be & ltmask); if (rk < kq) so[(256 - kq) + rk] = (u16)s; } \
                og += __popcll(bg); oe += __popcll(be); }
            for (int sb0 = slo; sb0 < shi; sb0 += 64) {
                const int s = sb0 + lane; const bool in = s < shi;
                const unsigned x0 = in ? (S[s] & pmask) : 0u, x1 = in ? (S[8192 + s] & pmask) : 0u, x2 = in ? (S[16384 + s] & pmask) : 0u, x3 = in ? (S[24576 + s] & pmask) : 0u;
                WR1(0, x0, T0, k0, og0, oe0) WR1(1, x1, T1, k1, og1, oe1) WR1(2, x2, T2, k2, og2, oe2) WR1(3, x3, T3, k3, og3, oe3)
            }
#undef WR1
        }
        __syncthreads();
    }
}

__device__ __forceinline__ void phase_post(const Params& p) {
    unsigned char* ws = p.ws;
    const float* YR = (const float*)(ws + OFF_YRAW);
    const half_t* VS = (const half_t*)(ws + OFF_VS);
    const half_t* G = (const half_t*)(ws + OFF_G);
    const float* RK = (const float*)(ws + OFF_RK);
    half_t* YA = (half_t*)(ws + OFF_D);
    const float* lg = p.in[I_LNG]; const float* lb = p.in[I_LNB];
    for (int i = blockIdx.x * NTHREADS + threadIdx.x; i < NTOK * 128; i += gridDim.x * NTHREADS) {
        const int m = i >> 7, n = (i & 127) * 4, h = n >> 6;
        const f4 y = *(const f4*)(YR + (size_t)m * 512 + n);
        const float mean = rowsum16(y[0] + y[1] + y[2] + y[3]) * (1.0f / 64.0f);
        const float d0 = y[0] - mean, d1 = y[1] - mean, d2 = y[2] - mean, d3 = y[3] - mean;
        const float var = rowsum16(d0 * d0 + d1 * d1 + d2 * d2 + d3 * d3) * (1.0f / 64.0f);
        const float rs = rsqrtf(var + 64e-5f);
        const f4 g4 = *(const f4*)(lg + n), b4 = *(const f4*)(lb + n);
        const h4 v4 = *(const h4*)(VS + (size_t)m * 512 + n), gg = *(const h4*)(G + (size_t)m * 512 + n);
        const float rk = RK[(size_t)m * 8 + h];
        const float o0 = (d0 * rs * g4[0] + b4[0] + rk * (float)v4[0]) * (float)gg[0];
        const float o1 = (d1 * rs * g4[1] + b4[1] + rk * (float)v4[1]) * (float)gg[1];
        const float o2 = (d2 * rs * g4[2] + b4[2] + rk * (float)v4[2]) * (float)gg[2];
        const float o3 = (d3 * rs * g4[3] + b4[3] + rk * (float)v4[3]) * (float)gg[3];
        *(h4*)(YA + (size_t)m * 512 + n) = pack4(o0, o1, o2, o3);
    }
}

__device__ __forceinline__ float dot8h(const h8 a, const h8 b) {
#if __has_builtin(__builtin_amdgcn_fdot2)
    float d = 0.f;
    d = __builtin_amdgcn_fdot2((h2){a[0], a[1]}, (h2){b[0], b[1]}, d, false);
    d = __builtin_amdgcn_fdot2((h2){a[2], a[3]}, (h2){b[2], b[3]}, d, false);
    d = __builtin_amdgcn_fdot2((h2){a[4], a[5]}, (h2){b[4], b[5]}, d, false);
    d = __builtin_amdgcn_fdot2((h2){a[6], a[7]}, (h2){b[6], b[7]}, d, false);
    return d;
#else
    float d = 0.f;
#pragma unroll
    for (int e = 0; e < 8; ++e) d += (float)a[e] * (float)b[e];
    return d;
#endif
}

__device__ __forceinline__ void phase_attn(const Params& p, unsigned char* lds, int blk0, int nblk) {
    unsigned char* ws = p.ws;
    const half_t* Q = (const half_t*)(ws + OFF_Q);
    const half_t* KH = (const half_t*)(ws + OFF_KH);
    const half_t* VH = (const half_t*)(ws + OFF_VH);
    const u16* SEL = (const u16*)(ws + OFF_SEL);
    half_t* YB = (half_t*)(ws + OFF_YB);
    const int tid = threadIdx.x, lane = tid & 63, wid = tid >> 6, g = lane >> 3, dq = lane & 7;
    int* offs = (int*)(lds + wid * 1024);
    const int bx = (int)blockIdx.x - blk0;
    if (bx < 0 || bx >= nblk) return;
    const int cls = blockIdx.x & 7;
    const int first = (cls - (blk0 & 7) + 8) & 7;
    const int ncls = (nblk - first + 7) >> 3;
    const int ib = (bx - first) >> 3;
    const int wv = ib * 8 + wid, nwv = ncls * 8;
    for (int bhi = 0; bhi < 4; ++bhi) {
        const int bh = cls + 8 * bhi, b = bh >> 3, h = bh & 7;
        const unsigned char* Kb = (const unsigned char*)(KH + (size_t)bh * SEQ * 64);
        const unsigned char* Vb = (const unsigned char*)(VH + (size_t)bh * SEQ * 64);
        int t = wv;
        unsigned sraw[4]; h8 qn;
#pragma unroll
        for (int e = 0; e < 8; ++e) qn[e] = (half_t)0.f;
#pragma unroll
        for (int i = 0; i < 4; ++i) sraw[i] = 0;
        if (t < SEQ) {
            const size_t row = (size_t)b * SEQ + t;
#pragma unroll
            for (int i = 0; i < 4; ++i) sraw[i] = SEL[row * 256 + lane + 64 * i];
            qn = *(const h8*)(Q + row * 512 + h * 64 + dq * 8);
        }
        for (; t < SEQ; t += nwv) {
            const size_t row = (size_t)b * SEQ + t;
#pragma unroll
            for (int i = 0; i < 4; ++i) { const unsigned idx = sraw[i] > 8191u ? 0u : sraw[i]; offs[lane + 64 * i] = (int)idx * 128; }
            const h8 q8 = qn;
            const int tn = t + nwv;
            if (tn < SEQ) {
                const size_t rown = (size_t)b * SEQ + tn;
#pragma unroll
                for (int i = 0; i < 4; ++i) sraw[i] = SEL[rown * 256 + lane + 64 * i];
                qn = *(const h8*)(Q + rown * 512 + h * 64 + dq * 8);
            }
            __builtin_amdgcn_wave_barrier();
            asm volatile("s_waitcnt lgkmcnt(0)" ::: "memory");
            unsigned of[32];
#pragma unroll
            for (int it = 0; it < 32; ++it) of[it] = (unsigned)offs[it * 8 + g] + (unsigned)dq * 16u;
            h8 kr[32];
#pragma unroll
            for (int it = 0; it < 32; ++it) kr[it] = *(const h8*)(Kb + of[it]);
            float lg[32];
            float mx = -INFINITY;
#pragma unroll
            for (int it = 0; it < 32; ++it) {
                float d = sum8(dot8h(q8, kr[it]));
                d = (it * 8 + g <= t) ? d : -INFINITY;
                lg[it] = d; mx = fmaxf(mx, d);
            }
            asm volatile("" : "+v"(mx) :: "memory");
            h8 vr[32];
#pragma unroll
            for (int it = 0; it < 32; ++it) vr[it] = *(const h8*)(Vb + of[it]);
            mx = fmaxf(mx, __shfl_xor(mx, 8)); mx = fmaxf(mx, __shfl_xor(mx, 16)); mx = fmaxf(mx, __shfl_xor(mx, 32));
            float sum = 0.f;
#pragma unroll
            for (int it = 0; it < 32; ++it) { lg[it] = __expf(lg[it] - mx); sum += lg[it]; }
            sum += __shfl_xor(sum, 8); sum += __shfl_xor(sum, 16); sum += __shfl_xor(sum, 32);
            float o[8];
#pragma unroll
            for (int e = 0; e < 8; ++e) o[e] = 0.f;
#pragma unroll
            for (int it = 0; it < 32; ++it)
#pragma unroll
                for (int e = 0; e < 8; ++e) o[e] += lg[it] * (float)vr[it][e];
            const float inv = 1.0f / sum;
#pragma unroll
            for (int e = 0; e < 8; ++e) { o[e] += __shfl_xor(o[e], 8); o[e] += __shfl_xor(o[e], 16); o[e] += __shfl_xor(o[e], 32); }
            if (g == 0) {
                h8 w;
#pragma unroll
                for (int e = 0; e < 8; ++e) w[e] = (half_t)(o[e] * inv);
                *(h8*)(YB + row * 512 + h * 64 + dq * 8) = w;
            }
            __builtin_amdgcn_wave_barrier();
        }
    }
}

__device__ __forceinline__ void phase_merge(const Params& p, unsigned char* lds) {
    unsigned char* ws = p.ws;
    const half_t* U = (const half_t*)(ws + OFF_U16);
    const half_t* WG = (const half_t*)(ws + OFF_WG);
    const half_t* YA = (const half_t*)(ws + OFF_D);
    const half_t* YB = (const half_t*)(ws + OFF_YB);
    half_t* MG = (half_t*)(ws + OFF_Q);
    const int tid = threadIdx.x, lane = tid & 63, wid = tid >> 6, wm = wid >> 1, wn = wid & 1, r31 = lane & 31, hh = lane >> 5;
    XCD_TILE_LOOP(8) {
        int mt, nt; xcd_tile(L_, 8, mt, nt); const int m0 = mt * 256, n0 = nt * 128;
        unsigned sg[2][2][8], mg[2][2][8];
        {
            f16v acc[2][2];
            gemm_main<2>(acc, U, 1024, WG, 1024, 1024, m0, n0, lds);
#pragma unroll
            for (int mi = 0; mi < 2; ++mi)
#pragma unroll
                for (int nj = 0; nj < 2; ++nj) {
#pragma unroll
                    for (int e = 0; e < 8; ++e) { h2 w; w[0] = (half_t)sigm(acc[mi][nj][2 * e]); w[1] = (half_t)sigm(acc[mi][nj][2 * e + 1]); sg[mi][nj][e] = __builtin_bit_cast(unsigned, w); }
                    asm volatile("" : "+v"(sg[mi][nj][0]), "+v"(sg[mi][nj][1]), "+v"(sg[mi][nj][2]), "+v"(sg[mi][nj][3]), "+v"(sg[mi][nj][4]), "+v"(sg[mi][nj][5]), "+v"(sg[mi][nj][6]), "+v"(sg[mi][nj][7]));
                }
        }
        {
            f16v acc[2][2];
            gemm_main<2>(acc, YA, 512, (const half_t*)(ws + OFF_WOR), 512, 512, m0, n0, lds);
#pragma unroll
            for (int mi = 0; mi < 2; ++mi)
#pragma unroll
                for (int nj = 0; nj < 2; ++nj) {
#pragma unroll
                    for (int e = 0; e < 8; ++e) { const h2 s2 = __builtin_bit_cast(h2, sg[mi][nj][e]); h2 w; w[0] = (half_t)(acc[mi][nj][2 * e] * (float)s2[0]); w[1] = (half_t)(acc[mi][nj][2 * e + 1] * (float)s2[1]); mg[mi][nj][e] = __builtin_bit_cast(unsigned, w); }
                    asm volatile("" : "+v"(mg[mi][nj][0]), "+v"(mg[mi][nj][1]), "+v"(mg[mi][nj][2]), "+v"(mg[mi][nj][3]), "+v"(mg[mi][nj][4]), "+v"(mg[mi][nj][5]), "+v"(mg[mi][nj][6]), "+v"(mg[mi][nj][7]));
                }
        }
        {
            f16v acc[2][2];
            gemm_main<2>(acc, U, 1024, WG + (size_t)1024 * 1024, 1024, 1024, m0, n0, lds);
#pragma unroll
            for (int mi = 0; mi < 2; ++mi)
#pragma unroll
                for (int nj = 0; nj < 2; ++nj) {
#pragma unroll
                    for (int e = 0; e < 8; ++e) { h2 w; w[0] = (half_t)sigm(acc[mi][nj][2 * e]); w[1] = (half_t)sigm(acc[mi][nj][2 * e + 1]); sg[mi][nj][e] = __builtin_bit_cast(unsigned, w); }
                    asm volatile("" : "+v"(sg[mi][nj][0]), "+v"(sg[mi][nj][1]), "+v"(sg[mi][nj][2]), "+v"(sg[mi][nj][3]), "+v"(sg[mi][nj][4]), "+v"(sg[mi][nj][5]), "+v"(sg[mi][nj][6]), "+v"(sg[mi][nj][7]));
                }
        }
        {
            f16v acc[2][2];
            gemm_main<2>(acc, YB, 512, (const half_t*)(ws + OFF_WOA), 512, 512, m0, n0, lds);
#pragma unroll
            for (int mi = 0; mi < 2; ++mi) {
                const int m = m0 + wm * 64 + mi * 32 + r31;
#pragma unroll
                for (int nj = 0; nj < 2; ++nj)
#pragma unroll
                    for (int rg = 0; rg < 4; ++rg) {
                        const int n = n0 + wn * 64 + nj * 32 + rg * 8 + hh * 4;
                        float o[4];
#pragma unroll
                        for (int e = 0; e < 4; ++e) { const int r = rg * 4 + e; const h2 m2 = __builtin_bit_cast(h2, mg[mi][nj][r >> 1]), s2 = __builtin_bit_cast(h2, sg[mi][nj][r >> 1]); o[e] = (float)m2[r & 1] + acc[mi][nj][r] * (float)s2[r & 1]; }
                        *(h4*)(MG + (size_t)m * 1024 + n) = pack4(o[0], o[1], o[2], o[3]);
                    }
            }
        }
    }
}

__device__ __forceinline__ void phase_outproj(const Params& p, unsigned char* lds) {
    const half_t* MG = (const half_t*)(p.ws + OFF_Q);
    const half_t* W = (const half_t*)(p.ws + OFF_WOUT);
    const float* x = p.in[I_X];
    const int tid = threadIdx.x, lane = tid & 63, wid = tid >> 6, wm = wid >> 1, wn = wid & 1, r31 = lane & 31, hh = lane >> 5;
    XCD_TILE_LOOP(4) {
        int mt, nt; xcd_tile(L_, 4, mt, nt); const int m0 = mt * 256, n0 = nt * 256;
        f16v acc[2][4];
        gemm_main<4>(acc, MG, 1024, W, 1024, 1024, m0, n0, lds);
#pragma unroll
        for (int mi = 0; mi < 2; ++mi) {
            const int m = m0 + wm * 64 + mi * 32 + r31;
#pragma unroll
            for (int nj = 0; nj < 4; ++nj)
#pragma unroll
                for (int rg = 0; rg < 4; ++rg) {
                    const size_t o = (size_t)m * 1024 + n0 + wn * 128 + nj * 32 + rg * 8 + hh * 4;
                    f4 v = *(const f4*)(x + o);
                    v[0] += acc[mi][nj][rg * 4]; v[1] += acc[mi][nj][rg * 4 + 1]; v[2] += acc[mi][nj][rg * 4 + 2]; v[3] += acc[mi][nj][rg * 4 + 3];
                    *(f4*)(p.out + o) = v;
                }
        }
    }
}

__device__ __forceinline__ void phase_ffn1(const Params& p, unsigned char* lds) {
    const half_t* U = (const half_t*)(p.ws + OFF_U16);
    const half_t* W = (const half_t*)(p.ws + OFF_WF1);
    half_t* ACT = (half_t*)(p.ws + OFF_PR);
    const int tid = threadIdx.x, lane = tid & 63, wid = tid >> 6, wm = wid >> 1, wn = wid & 1, r31 = lane & 31, hh = lane >> 5;
    XCD_TILE_LOOP(22) {
        int mt, nt; xcd_tile(L_, 22, mt, nt); const int m0 = mt * 256, n0 = nt * 256;
        f16v acc[2][4];
        gemm_main<4>(acc, U, 1024, W, 1024, 1024, m0, n0, lds);
#pragma unroll
        for (int mi = 0; mi < 2; ++mi) {
            const int m = m0 + wm * 64 + mi * 32 + r31;
#pragma unroll
            for (int pr = 0; pr < 2; ++pr)
#pragma unroll
                for (int rg = 0; rg < 4; ++rg) {
                    const int c = ((n0 + wn * 128) >> 1) + pr * 32 + rg * 8 + hh * 4;
                    float o[4];
#pragma unroll
                    for (int e = 0; e < 4; ++e) { const float gt = acc[mi][2 * pr][rg * 4 + e], up = acc[mi][2 * pr + 1][rg * 4 + e]; o[e] = gt * sigm(gt) * up; }
                    *(h4*)(ACT + (size_t)m * 2816 + c) = pack4(o[0], o[1], o[2], o[3]);
                }
        }
    }
}

__device__ __forceinline__ void phase_ffn2(const Params& p, unsigned char* lds) {
    const half_t* ACT = (const half_t*)(p.ws + OFF_PR);
    const half_t* W = (const half_t*)(p.ws + OFF_WF2);
    const int tid = threadIdx.x, lane = tid & 63, wid = tid >> 6, wm = wid >> 1, wn = wid & 1, r31 = lane & 31, hh = lane >> 5;
    XCD_TILE_LOOP(4) {
        int mt, nt; xcd_tile(L_, 4, mt, nt); const int m0 = mt * 256, n0 = nt * 256;
        f16v acc[2][4];
        gemm_main<4>(acc, ACT, 2816, W, 2816, 2816, m0, n0, lds);
#pragma unroll
        for (int mi = 0; mi < 2; ++mi) {
            const int m = m0 + wm * 64 + mi * 32 + r31;
#pragma unroll
            for (int nj = 0; nj < 4; ++nj)
#pragma unroll
                for (int rg = 0; rg < 4; ++rg) {
                    const size_t o = (size_t)m * 1024 + n0 + wn * 128 + nj * 32 + rg * 8 + hh * 4;
                    f4 v = *(const f4*)(p.out + o);
                    v[0] += acc[mi][nj][rg * 4]; v[1] += acc[mi][nj][rg * 4 + 1]; v[2] += acc[mi][nj][rg * 4 + 2]; v[3] += acc[mi][nj][rg * 4 + 3];
                    *(f4*)(p.out + o) = v;
                }
        }
    }
}

__device__ __forceinline__ void phase_final(const Params& p) {
    const int lane = threadIdx.x & 63, wid = threadIdx.x >> 6;
    const float* g = p.in[I_NFG];
    for (int row = blockIdx.x * 8 + wid; row < NTOK; row += gridDim.x * 8) {
        f4* xr = (f4*)(p.out + (size_t)row * 1024);
        f4 v[4]; float ss = 0.f;
#pragma unroll
        for (int i = 0; i < 4; ++i) { v[i] = xr[lane + 64 * i]; ss += v[i][0] * v[i][0] + v[i][1] * v[i][1] + v[i][2] * v[i][2] + v[i][3] * v[i][3]; }
        ss = wave_sum(ss);
        const float rs = rsqrtf(ss * (1.0f / 1024.0f) + 1e-6f);
#pragma unroll
        for (int i = 0; i < 4; ++i) {
            const f4 gg = ((const f4*)g)[lane + 64 * i];
            f4 w; w[0] = v[i][0] * rs * gg[0]; w[1] = v[i][1] * rs * gg[1]; w[2] = v[i][2] * rs * gg[2]; w[3] = v[i][3] * rs * gg[3];
            xr[lane + 64 * i] = w;
        }
    }
}

#define NPHASES 13
__global__ void __launch_bounds__(NTHREADS) mk_fwd(Params p, int ph_lo, int ph_hi, int coop) {
    extern __shared__ __attribute__((aligned(16))) unsigned char lds[];
    cg::grid_group grid = cg::this_grid();
#define PHASE(id, body) if (ph_lo <= id && id < ph_hi) { int reps_ = (id == PROBE_DUP) ? 2 : 1; if (id == PROBE_DUP) asm volatile("" : "+s"(reps_)); _Pragma("nounroll") for (int rep_ = 0; rep_ < reps_; ++rep_) { body; if (rep_ + 1 < reps_) grid.sync(); } if (coop && id + 1 < ph_hi) grid.sync(); }
    PHASE(0, phase_convert(p, lds))
    PHASE(1, phase_inproj(p, lds))
    PHASE(2, phase_prep(p))
    PHASE(3, phase_lora(p, lds))
    PHASE(4, { if (blockIdx.x < 64) phase_scan(p); else phase_indexer(p, lds, 64, (int)gridDim.x - 64); })
    PHASE(6, { phase_post(p); phase_attn(p, lds, 0, gridDim.x); })
    PHASE(7, phase_merge(p, lds))
    PHASE(8, phase_outproj(p, lds))
    PHASE(9, rmsnorm_rows_f16(p.out, p.in[I_N2G], (half_t*)(p.ws + OFF_U16)))
    PHASE(10, phase_ffn1(p, lds))
    PHASE(11, phase_ffn2(p, lds))
    PHASE(12, phase_final(p))
#undef PHASE
}

#ifndef MK_COOP
#define MK_COOP 1
#endif

extern "C" void kernel_launch(void* const* d_in, const int* in_sizes, int n_in, void* d_out, int out_size, void* d_ws, size_t ws_size, hipStream_t stream) {
    static int grid = 0;
    if (grid == 0) {
        if (n_in != 21 || out_size != NTOK * 1024 || ws_size < WS_END) { fprintf(stderr, "kernel_launch: unexpected shapes (n_in %d out %d ws %zu, need %zu)\n", n_in, out_size, ws_size, (size_t)WS_END); grid = -1; return; }
        int dev = 0, cus = 0, per_cu = 0;
        (void)hipGetDevice(&dev);
        (void)hipDeviceGetAttribute(&cus, hipDeviceAttributeMultiprocessorCount, dev);
        if (hipFuncSetAttribute((const void*)mk_fwd, hipFuncAttributeMaxDynamicSharedMemorySize, LDS_BYTES) != hipSuccess) { fprintf(stderr, "kernel_launch: hipFuncSetAttribute failed\n"); grid = -1; return; }
        if (hipOccupancyMaxActiveBlocksPerMultiprocessor(&per_cu, (const void*)mk_fwd, NTHREADS, LDS_BYTES) != hipSuccess || per_cu < 1) { fprintf(stderr, "kernel_launch: occupancy query gave %d\n", per_cu); per_cu = 1; }
        (void)hipGetLastError();
        grid = cus * per_cu;
        grid &= ~7;
        if (grid < 72) grid = 72;
    }
    if (grid < 0) return;
    Params p;
    memset(&p, 0, sizeof(p));
    for (int i = 0; i < 21; ++i) p.in[i] = (const float*)d_in[i];
    p.out = (float*)d_out; p.ws = (unsigned char*)d_ws;
    for (int j = 0; j < 32; ++j) p.invf[j] = pow(10000.0, -(double)j / 32.0);
#if MK_COOP
    int lo = 0, hi = NPHASES, coop = 1;
    void* args[] = {&p, &lo, &hi, &coop};
    hipError_t e = hipLaunchCooperativeKernel((const void*)mk_fwd, dim3(grid), dim3(NTHREADS), args, LDS_BYTES, stream);
    if (e != hipSuccess) fprintf(stderr, "cooperative launch failed: %s (grid %d)\n", hipGetErrorString(e), grid);
#else
    for (int ph = 0; ph < NPHASES; ++ph)
        hipLaunchKernelGGL(mk_fwd, dim3(grid), dim3(NTHREADS), LDS_BYTES, stream, p, ph, ph + 1, 0);
#endif
}
```

```cpp
#include <hip/hip_runtime.h>
#include <hip/hip_cooperative_groups.h>
#include <cstdio>
#include <cmath>
#include <cstring>
namespace cg = cooperative_groups;

typedef _Float16 half_t;
typedef _Float16 h8 __attribute__((ext_vector_type(8)));
typedef _Float16 h4 __attribute__((ext_vector_type(4)));
typedef _Float16 h2 __attribute__((ext_vector_type(2)));
typedef float f16v __attribute__((ext_vector_type(16)));
typedef float f4 __attribute__((ext_vector_type(4)));
typedef unsigned short u16;
typedef unsigned u32x4 __attribute__((ext_vector_type(4)));
typedef int i32x4 __attribute__((ext_vector_type(4)));

#define NTOK 32768
#define SEQ 8192
#define NTHREADS 512
#ifndef PROBE_DUP
#define PROBE_DUP -1
#endif
#ifndef LORA_PARTS
#define LORA_PARTS 7
#endif
#define LDS_BYTES 151552

constexpr size_t OFF_WIN  = 0;
constexpr size_t OFF_WG   = OFF_WIN  + 8388608;
constexpr size_t OFF_WD   = OFF_WG   + 4194304;
constexpr size_t OFF_AUP  = OFF_WD   + 65536;
constexpr size_t OFF_GUP  = OFF_AUP  + 65536;
constexpr size_t OFF_WOR  = OFF_GUP  + 131072;
constexpr size_t OFF_WOA  = OFF_WOR  + 1048576;
constexpr size_t OFF_WOUT = OFF_WOA  + 1048576;
constexpr size_t OFF_WF1  = OFF_WOUT + 2097152;
constexpr size_t OFF_WF2  = OFF_WF1  + 11534336;
constexpr size_t OFF_ROPE = OFF_WF2  + 5767168;
constexpr size_t OFF_U16  = OFF_ROPE + 2097152;
constexpr size_t OFF_Q    = OFF_U16  + 67108864;
constexpr size_t OFF_KH   = OFF_Q    + 33554432;
constexpr size_t OFF_VH   = OFF_KH   + 33554432;
constexpr size_t OFF_QI   = OFF_VH   + 33554432;
constexpr size_t OFF_KI   = OFF_QI   + 33554432;
constexpr size_t OFF_WI   = OFF_KI   + 4194304;
constexpr size_t OFF_PR   = OFF_WI   + 1048576;
constexpr size_t OFF_YRAW = OFF_PR;
constexpr size_t OFF_YB   = OFF_PR + 67108864;
constexpr size_t OFF_SEL  = OFF_YB + 33554432;
constexpr size_t OFF_LA   = OFF_PR   + 117440512;
constexpr size_t OFF_D    = OFF_LA   + 16777216;
constexpr size_t OFF_VS   = OFF_D    + 67108864;
constexpr size_t OFF_G    = OFF_VS   + 33554432;
constexpr size_t OFF_RK   = OFF_G    + 33554432;
constexpr size_t WS_END   = OFF_RK   + 1048576;

struct Params {
    const float* in[21];
    float* out;
    unsigned char* ws;
    double invf[32];
};
enum { I_X = 0, I_N1G, I_WIN, I_MU, I_WDU, I_W0, I_AUP, I_A0, I_GUP, I_KK, I_KA, I_RK, I_LNG, I_LNB, I_WOR, I_WOA, I_WOUT, I_N2G, I_WF1, I_WF2, I_NFG };

__device__ __forceinline__ float sigm(float x) { return 1.0f / (1.0f + __expf(-x)); }

template <int CTRL> __device__ __forceinline__ float dppf(float x) {
    return __int_as_float(__builtin_amdgcn_mov_dpp(__float_as_int(x), CTRL, 0xf, 0xf, true));
}
__device__ __forceinline__ float rowsum16(float x) {
    x += dppf<0x128>(x); x += dppf<0x124>(x); x += dppf<0x122>(x); x += dppf<0x121>(x); return x;
}
__device__ __forceinline__ float sum8(float x) {
    x += dppf<0xB1>(x); x += dppf<0x4E>(x); x += dppf<0x141>(x); return x;
}
__device__ __forceinline__ float wave_sum(float x) {
#pragma unroll
    for (int o = 32; o >= 1; o >>= 1) x += __shfl_xor(x, o);
    return x;
}
__device__ __forceinline__ float wave_max(float x) {
#pragma unroll
    for (int o = 32; o >= 1; o >>= 1) x = fmaxf(x, __shfl_xor(x, o));
    return x;
}

__device__ __forceinline__ int colmap(int mode, int n) {
    if (mode == 1) return n < 3912 ? n : -1;
    if (mode == 2) return 3912 + n;
    if (mode == 3) { const int g = n >> 6, r = n & 63; return r < 32 ? g * 32 + r : 2816 + g * 32 + (r - 32); }
    return n;
}
__device__ __forceinline__ void conv_tile(const float* __restrict__ src, int ldsrc, int K, int mode, half_t* __restrict__ dst, int kt, int nt, float* tile) {
    const int tid = threadIdx.x;
    const int nn = tid & 63, kk = tid >> 6;
    const int col = colmap(mode, nt * 64 + nn);
#pragma unroll
    for (int i = 0; i < 8; ++i) {
        const int k = kk + 8 * i;
        tile[k * 65 + nn] = col >= 0 ? src[(size_t)(kt * 64 + k) * ldsrc + col] : 0.f;
    }
    __syncthreads();
#pragma unroll
    for (int i = 0; i < 8; ++i) {
        const int n = kk + 8 * i;
        dst[(size_t)(nt * 64 + n) * K + kt * 64 + nn] = (half_t)tile[nn * 65 + n];
    }
    __syncthreads();
}

__device__ __forceinline__ void sincos_d(double a, float& c, float& s) {
    const double n = rint(a * 0.63661977236758134308);
    double r = fma(-n, 1.57079632679489655800e+00, a);
    r = fma(-n, 6.12323399573676603587e-17, r);
    const double r2 = r * r;
    double sp = -1.0 / 1307674368000.0;
    sp = fma(sp, r2, 1.0 / 6227020800.0);
    sp = fma(sp, r2, -1.0 / 39916800.0);
    sp = fma(sp, r2, 1.0 / 362880.0);
    sp = fma(sp, r2, -1.0 / 5040.0);
    sp = fma(sp, r2, 1.0 / 120.0);
    sp = fma(sp, r2, -1.0 / 6.0);
    const double sn = fma(sp * r2, r, r);
    double cp = 1.0 / 20922789888000.0;
    cp = fma(cp, r2, -1.0 / 87178291200.0);
    cp = fma(cp, r2, 1.0 / 479001600.0);
    cp = fma(cp, r2, -1.0 / 3628800.0);
    cp = fma(cp, r2, 1.0 / 40320.0);
    cp = fma(cp, r2, -1.0 / 720.0);
    cp = fma(cp, r2, 1.0 / 24.0);
    cp = fma(cp, r2, -0.5);
    const double cs = fma(cp, r2, 1.0);
    const int q = ((int)n) & 3;
    double cc = (q & 1) ? sn : cs, ss = (q & 1) ? cs : sn;
    if (q == 1 || q == 2) cc = -cc;
    if (q == 2 || q == 3) ss = -ss;
    c = (float)cc; s = (float)ss;
}

__device__ __forceinline__ void rmsnorm_rows_f16(const float* __restrict__ x, const float* __restrict__ g, half_t* __restrict__ o) {
    const int lane = threadIdx.x & 63, wid = threadIdx.x >> 6;
    for (int row = blockIdx.x * 8 + wid; row < NTOK; row += gridDim.x * 8) {
        const f4* xr = (const f4*)(x + (size_t)row * 1024);
        f4 v[4]; float ss = 0.f;
#pragma unroll
        for (int i = 0; i < 4; ++i) { v[i] = xr[lane + 64 * i]; ss += v[i][0] * v[i][0] + v[i][1] * v[i][1] + v[i][2] * v[i][2] + v[i][3] * v[i][3]; }
        ss = wave_sum(ss);
        const float rs = rsqrtf(ss * (1.0f / 1024.0f) + 1e-6f);
#pragma unroll
        for (int i = 0; i < 4; ++i) {
            const f4 gg = ((const f4*)g)[lane + 64 * i];
            h4 w; w[0] = (half_t)(v[i][0] * rs * gg[0]); w[1] = (half_t)(v[i][1] * rs * gg[1]); w[2] = (half_t)(v[i][2] * rs * gg[2]); w[3] = (half_t)(v[i][3] * rs * gg[3]);
            *(h4*)(o + (size_t)row * 1024 + (lane + 64 * i) * 4) = w;
        }
    }
}

__device__ __forceinline__ void phase_convert(const Params& p, unsigned char* lds) {
    float* tile = (float*)lds;
    unsigned char* ws = p.ws;
    const int total = 1024 + 512 + 8 + 8 + 16 + 128 + 128 + 256 + 1408 + 704;
    for (int t = blockIdx.x; t < total; t += gridDim.x) {
        int j, r;
        if (t < 1024) { j = 0; r = t; } else if (t < 1536) { j = 1; r = t - 1024; } else if (t < 1544) { j = 2; r = t - 1536; } else if (t < 1552) { j = 3; r = t - 1544; }
        else if (t < 1568) { j = 4; r = t - 1552; } else if (t < 1696) { j = 5; r = t - 1568; } else if (t < 1824) { j = 6; r = t - 1696; } else if (t < 2080) { j = 7; r = t - 1824; }
        else if (t < 3488) { j = 8; r = t - 2080; } else { j = 9; r = t - 3488; }
        if (j == 0) conv_tile(p.in[I_WIN], 5960, 1024, 1, (half_t*)(ws + OFF_WIN), r / 64, r % 64, tile);
        else if (j == 1) conv_tile(p.in[I_WIN], 5960, 1024, 2, (half_t*)(ws + OFF_WG), r / 32, r % 32, tile);
        else if (j == 2) conv_tile(p.in[I_WDU], 512, 64, 0, (half_t*)(ws + OFF_WD), r / 8, r % 8, tile);
        else if (j == 3) conv_tile(p.in[I_AUP], 512, 64, 0, (half_t*)(ws + OFF_AUP), r / 8, r % 8, tile);
        else if (j == 4) conv_tile(p.in[I_GUP], 512, 128, 0, (half_t*)(ws + OFF_GUP), r / 8, r % 8, tile);
        else if (j == 5) conv_tile(p.in[I_WOR], 1024, 512, 0, (half_t*)(ws + OFF_WOR), r / 16, r % 16, tile);
        else if (j == 6) conv_tile(p.in[I_WOA], 1024, 512, 0, (half_t*)(ws + OFF_WOA), r / 16, r % 16, tile);
        else if (j == 7) conv_tile(p.in[I_WOUT], 1024, 1024, 0, (half_t*)(ws + OFF_WOUT), r / 16, r % 16, tile);
        else if (j == 8) conv_tile(p.in[I_WF1], 5632, 1024, 3, (half_t*)(ws + OFF_WF1), r / 88, r % 88, tile);
        else conv_tile(p.in[I_WF2], 1024, 2816, 0, (half_t*)(ws + OFF_WF2), r / 16, r % 16, tile);
    }
    float2* rope = (float2*)(ws + OFF_ROPE);
    for (int i = blockIdx.x * NTHREADS + threadIdx.x; i < SEQ * 32; i += gridDim.x * NTHREADS) {
        const int pos = i >> 5, j = i & 31;
        float c, s; sincos_d((double)pos * p.invf[j], c, s);
        rope[i] = make_float2(c, s);
    }
    rmsnorm_rows_f16(p.in[I_X], p.in[I_N1G], (half_t*)(ws + OFF_U16));
}

__device__ __forceinline__ u32x4 gload_asm(const void* p) {
    u32x4 r;
    asm volatile("global_load_dwordx4 %0, %1, off" : "=&v"(r) : "v"(p) : "memory");
    return r;
}
__device__ __forceinline__ u32x4 gload_asm_s(const void* sbase, unsigned voff) {
    u32x4 r;
    asm volatile("global_load_dwordx4 %0, %1, %2" : "=&v"(r) : "v"(voff), "s"(sbase) : "memory");
    return r;
}
template <int NJ>
__device__ __forceinline__ void gemm_main(f16v (&acc)[2][NJ], const half_t* __restrict__ A, int lda, const half_t* __restrict__ Bt, int ldb, int K, int m0, int n0, unsigned char* lds) {
    const int tid = threadIdx.x, lane = tid & 63, wid = tid >> 6, wm = wid >> 1, wn = wid & 1;
    constexpr int NB = NJ;
    constexpr int STAGE = 32768 + 64 * NJ * 128;
#pragma unroll
    for (int mi = 0; mi < 2; ++mi)
#pragma unroll
        for (int nj = 0; nj < NJ; ++nj)
#pragma unroll
            for (int e = 0; e < 16; ++e) acc[mi][nj][e] = 0.f;
    const int srow = tid >> 3, sch = tid & 7;
    const int swz_w = (sch ^ ((srow >> 1) & 7)) << 4;
    const half_t* Ag = A + (size_t)(m0 + srow) * lda + sch * 8;
    const half_t* Bg = Bt + (size_t)(n0 + srow) * ldb + sch * 8;
    u32x4 ra[4], rb[NB];
    const int nk = K >> 6;
#pragma unroll
    for (int i = 0; i < 4; ++i) ra[i] = *(const u32x4*)(Ag + (size_t)i * 64 * lda);
#pragma unroll
    for (int i = 0; i < NB; ++i) rb[i] = *(const u32x4*)(Bg + (size_t)i * 64 * ldb);
    __syncthreads();
#pragma unroll
    for (int i = 0; i < 4; ++i) *(u32x4*)(lds + (srow + 64 * i) * 128 + swz_w) = ra[i];
#pragma unroll
    for (int i = 0; i < NB; ++i) *(u32x4*)(lds + 32768 + (srow + 64 * i) * 128 + swz_w) = rb[i];
    {
        const int k0 = (nk > 1 ? 1 : 0) * 64;
#pragma unroll
        for (int i = 0; i < 4; ++i) ra[i] = *(const u32x4*)(Ag + (size_t)i * 64 * lda + k0);
#pragma unroll
        for (int i = 0; i < NB; ++i) rb[i] = *(const u32x4*)(Bg + (size_t)i * 64 * ldb + k0);
    }
    const int r31 = lane & 31, hh = lane >> 5;
    const int swz_r = (r31 >> 1) & 7;
    for (int kt = 0; kt < nk; ++kt) {
        __syncthreads();
        {
            unsigned char* nb = lds + ((kt + 1) & 1) * STAGE;
#pragma unroll
            for (int i = 0; i < 4; ++i) *(u32x4*)(nb + (srow + 64 * i) * 128 + swz_w) = ra[i];
#pragma unroll
            for (int i = 0; i < NB; ++i) *(u32x4*)(nb + 32768 + (srow + 64 * i) * 128 + swz_w) = rb[i];
            const int k0 = (kt + 2 < nk ? kt + 2 : nk - 1) * 64;
#pragma unroll
            for (int i = 0; i < 4; ++i) ra[i] = *(const u32x4*)(Ag + (size_t)i * 64 * lda + k0);
#pragma unroll
            for (int i = 0; i < NB; ++i) rb[i] = *(const u32x4*)(Bg + (size_t)i * 64 * ldb + k0);
            __builtin_amdgcn_sched_barrier(0);
        }
        const unsigned char* base = lds + (kt & 1) * STAGE;
        const unsigned char* aB = base + (wm * 64 + r31) * 128;
        const unsigned char* bB = base + 32768 + (wn * 32 * NJ + r31) * 128;
#pragma unroll
        for (int ks = 0; ks < 4; ++ks) {
            const int co = ((ks * 2 + hh) ^ swz_r) << 4;
            h8 af[2], bf[NJ];
#pragma unroll
            for (int mi = 0; mi < 2; ++mi) af[mi] = *(const h8*)(aB + mi * 32 * 128 + co);
#pragma unroll
            for (int nj = 0; nj < NJ; ++nj) bf[nj] = *(const h8*)(bB + nj * 32 * 128 + co);
#pragma unroll
            for (int mi = 0; mi < 2; ++mi)
#pragma unroll
                for (int nj = 0; nj < NJ; ++nj) acc[mi][nj] = __builtin_amdgcn_mfma_f32_32x32x16_f16(bf[nj], af[mi], acc[mi][nj], 0, 0, 0);
        }
    }
    asm volatile("s_waitcnt vmcnt(0)" ::: "memory");
}

#define XCD_TILE_LOOP(NTn) for (int L_ = (int)blockIdx.x >> 3; L_ < 16 * (NTn); L_ += (int)gridDim.x >> 3)
__device__ __forceinline__ void xcd_tile(int L, int NTn, int& mt, int& nt) {
    const int per = 8 * NTn, mh = L / per, rem = L - mh * per;
    nt = rem >> 3; mt = ((int)blockIdx.x & 7) * 16 + mh * 8 + (rem & 7);
}
__device__ __forceinline__ h4 pack4(float a, float b, float c, float d) { h4 w; w[0] = (half_t)a; w[1] = (half_t)b; w[2] = (half_t)c; w[3] = (half_t)d; return w; }

__device__ __forceinline__ void epi_inproj(const Params& p, f16v (&acc)[2][4], int m0, int n0) {
    const int tid = threadIdx.x, lane = tid & 63, wid = tid >> 6, wm = wid >> 1, wn = wid & 1, r31 = lane & 31, hh = lane >> 5;
    const int nb = n0 + wn * 128;
    if (nb >= 3968) return;
    unsigned char* ws = p.ws;
    const float2* rope = (const float2*)(ws + OFF_ROPE);
#pragma unroll
    for (int mi = 0; mi < 2; ++mi) {
        const int m = m0 + wm * 64 + mi * 32 + r31, pos = m & (SEQ - 1), b = m >> 13;
        if (nb < 1792) {
            half_t* dst = (half_t*)(ws + OFF_PR) + (size_t)m * 1792 + nb + hh * 4;
#pragma unroll
            for (int nj = 0; nj < 4; ++nj)
#pragma unroll
                for (int rg = 0; rg < 4; ++rg)
                    *(h4*)(dst + nj * 32 + rg * 8) = pack4(acc[mi][nj][rg * 4], acc[mi][nj][rg * 4 + 1], acc[mi][nj][rg * 4 + 2], acc[mi][nj][rg * 4 + 3]);
        } else {
#pragma unroll
            for (int hd = 0; hd < 2; ++hd) {
                const int nh = nb + hd * 64;
                half_t* dst; bool dorope = true, kifrag = false; float sc = 1.0f;
                if (nh < 2304) { dst = (half_t*)(ws + OFF_Q) + (size_t)m * 512 + (nh - 1792); sc = 0.125f; }
                else if (nh < 2816) { dst = (half_t*)(ws + OFF_KH) + ((size_t)(b * 8 + ((nh - 2304) >> 6)) * SEQ + pos) * 64; }
                else if (nh < 3328) { dst = (half_t*)(ws + OFF_VH) + ((size_t)(b * 8 + ((nh - 2816) >> 6)) * SEQ + pos) * 64; dorope = false; }
                else if (nh < 3840) { dst = (half_t*)(ws + OFF_QI) + (size_t)m * 512 + (nh - 3328); }
                else if (nh == 3840) { dst = (half_t*)(ws + OFF_KI); kifrag = true; }
                else {
                    if (hd == 1) {
                        f4 w;
                        w[0] = acc[mi][2][0] * 0.044194173824159216f; w[1] = acc[mi][2][1] * 0.044194173824159216f;
                        w[2] = acc[mi][2][2] * 0.044194173824159216f; w[3] = acc[mi][2][3] * 0.044194173824159216f;
                        *(f4*)((float*)(ws + OFF_WI) + (size_t)m * 8 + hh * 4) = w;
                    }
                    continue;
                }
#pragma unroll
                for (int rg = 0; rg < 4; ++rg) {
                    const int d = rg * 8 + hh * 4;
                    float o1[4], o2[4];
                    if (dorope) {
                        const f4 cs0 = *(const f4*)(rope + pos * 32 + d), cs1 = *(const f4*)(rope + pos * 32 + d + 2);
                        const float c[4] = {cs0[0], cs0[2], cs1[0], cs1[2]}, s[4] = {cs0[1], cs0[3], cs1[1], cs1[3]};
#pragma unroll
                        for (int e = 0; e < 4; ++e) {
                            const float x1 = acc[mi][2 * hd][rg * 4 + e], x2 = acc[mi][2 * hd + 1][rg * 4 + e];
                            o1[e] = (x1 * c[e] - x2 * s[e]) * sc; o2[e] = (x1 * s[e] + x2 * c[e]) * sc;
                        }
                    } else {
#pragma unroll
                        for (int e = 0; e < 4; ++e) { o1[e] = acc[mi][2 * hd][rg * 4 + e]; o2[e] = acc[mi][2 * hd + 1][rg * 4 + e]; }
                    }
                    if (kifrag) {
                        const size_t cb = (size_t)(m >> 5) * 4, rr = (size_t)(m & 31);
                        const int da = d, db = d + 32;
                        *(h4*)(dst + (((cb + (da >> 4)) * 64 + ((da >> 3) & 1) * 32 + rr) * 8 + (da & 7))) = pack4(o1[0], o1[1], o1[2], o1[3]);
                        *(h4*)(dst + (((cb + (db >> 4)) * 64 + ((db >> 3) & 1) * 32 + rr) * 8 + (db & 7))) = pack4(o2[0], o2[1], o2[2], o2[3]);
                    } else {
                        *(h4*)(dst + d) = pack4(o1[0], o1[1], o1[2], o1[3]);
                        *(h4*)(dst + d + 32) = pack4(o2[0], o2[1], o2[2], o2[3]);
                    }
                }
            }
        }
    }
}

__device__ __forceinline__ void phase_inproj(const Params& p, unsigned char* lds) {
    const half_t* A = (const half_t*)(p.ws + OFF_U16);
    const half_t* Bt = (const half_t*)(p.ws + OFF_WIN);
    XCD_TILE_LOOP(16) {
        int mt, nt; xcd_tile(L_, 16, mt, nt);
        f16v acc[2][4];
        gemm_main<4>(acc, A, 1024, Bt, 1024, 1024, mt * 256, nt * 256, lds);
        epi_inproj(p, acc, mt * 256, nt * 256);
    }
}

__device__ __forceinline__ void phase_prep(const Params& p) {
    const half_t* PR = (const half_t*)(p.ws + OFF_PR);
    half_t* LA = (half_t*)(p.ws + OFF_LA);
    const float* mu = p.in[I_MU];
    for (int i = blockIdx.x * NTHREADS + threadIdx.x; i < NTOK * 32; i += gridDim.x * NTHREADS) {
        const int m = i >> 5, c8 = (i & 31) * 8, pos = m & (SEQ - 1);
        const h8 cur = *(const h8*)(PR + (size_t)m * 1792 + 1536 + c8);
        h8 prv;
        if (pos > 0) prv = *(const h8*)(PR + (size_t)(m - 1) * 1792 + 1536 + c8);
        else {
#pragma unroll
            for (int e = 0; e < 8; ++e) prv[e] = (half_t)0.f;
        }
        h8 o;
#pragma unroll
        for (int e = 0; e < 8; ++e) {
            const float x = (float)cur[e], xp = (float)prv[e];
            const float s = x + (xp - x) * mu[1536 + c8 + e];
            float r;
            if (c8 < 64) r = tanhf(s); else if (c8 < 128) r = s; else r = sigm(s);
            o[e] = (half_t)r;
        }
        *(h8*)(LA + (size_t)m * 256 + c8) = o;
    }
}

__device__ __forceinline__ void ld_shift4(const half_t* cur, const half_t* prv, bool hasprev, const float* mu, float (&o)[4]) {
    const h4 a = *(const h4*)cur;
    h4 b;
    if (hasprev) b = *(const h4*)prv; else { b[0] = (half_t)0.f; b[1] = (half_t)0.f; b[2] = (half_t)0.f; b[3] = (half_t)0.f; }
    const f4 m4 = *(const f4*)mu;
#pragma unroll
    for (int e = 0; e < 4; ++e) { const float x = (float)a[e], xp = (float)b[e]; o[e] = x + (xp - x) * m4[e]; }
}

__device__ __forceinline__ void phase_lora(const Params& p, unsigned char* lds) {
    unsigned char* ws = p.ws;
    const half_t* LA = (const half_t*)(ws + OFF_LA);
    const half_t* PR = (const half_t*)(ws + OFF_PR);
    const int tid = threadIdx.x, lane = tid & 63, wid = tid >> 6, wm = wid >> 1, wn = wid & 1, r31 = lane & 31, hh = lane >> 5;
    if (LORA_PARTS & 1) for (int t = blockIdx.x; t < 128 * 2; t += gridDim.x) {
        const int mt = t >> 1, nt = t & 1, m0 = mt * 256, n0 = nt * 256, nb = n0 + wn * 128;
        f16v acc[2][4];
        gemm_main<4>(acc, LA, 256, (const half_t*)(ws + OFF_WD), 64, 64, m0, n0, lds);
        const float* w0 = p.in[I_W0];
#pragma unroll
        for (int mi = 0; mi < 2; ++mi) {
            const int m = m0 + wm * 64 + mi * 32 + r31, pos = m & (SEQ - 1), b = m >> 13;
#pragma unroll
            for (int nj = 0; nj < 4; ++nj)
#pragma unroll
                for (int rg = 0; rg < 4; ++rg) {
                    const int n = nb + nj * 32 + rg * 8 + hh * 4, h = n >> 6, j = n & 63;
                    const f4 w04 = *(const f4*)(w0 + n);
                    f4 dv;
#pragma unroll
                    for (int e = 0; e < 4; ++e) {
                        const float z = w04[e] + acc[mi][nj][rg * 4 + e];
                        dv[e] = __expf(-0.60653065971263342f / (1.0f + __expf(-z)));
                    }
                    *(f4*)((float*)(ws + OFF_D) + ((size_t)(b * 8 + h) * SEQ + pos) * 64 + j) = dv;
                }
        }
    }
    if (LORA_PARTS & 2) for (int t = blockIdx.x; t < 128 * 2; t += gridDim.x) {
        const int mt = t >> 1, nt = t & 1, m0 = mt * 256, n0 = nt * 256, nb = n0 + wn * 128;
        f16v acc[2][4];
        gemm_main<4>(acc, LA + 128, 256, (const half_t*)(ws + OFF_GUP), 128, 128, m0, n0, lds);
#pragma unroll
        for (int mi = 0; mi < 2; ++mi) {
            const int m = m0 + wm * 64 + mi * 32 + r31;
            half_t* G = (half_t*)(ws + OFF_G) + (size_t)m * 512 + nb + hh * 4;
#pragma unroll
            for (int nj = 0; nj < 4; ++nj)
#pragma unroll
                for (int rg = 0; rg < 4; ++rg)
                    *(h4*)(G + nj * 32 + rg * 8) = pack4(acc[mi][nj][rg * 4], acc[mi][nj][rg * 4 + 1], acc[mi][nj][rg * 4 + 2], acc[mi][nj][rg * 4 + 3]);
        }
    }
    if (LORA_PARTS & 4) for (int t = blockIdx.x; t < 128 * 4; t += gridDim.x) {
        const int mt = t >> 2, nt = t & 3, m0 = mt * 256, n0 = nt * 128;
        f16v acc[2][2];
        gemm_main<2>(acc, LA + 64, 256, (const half_t*)(ws + OFF_AUP), 64, 64, m0, n0, lds);
        const float* mu = p.in[I_MU]; const float* a0 = p.in[I_A0]; const float* kkw = p.in[I_KK]; const float* kaw = p.in[I_KA]; const float* rkw = p.in[I_RK];
        {
            const int h = (n0 >> 6) + wn;
#pragma unroll
            for (int mi = 0; mi < 2; ++mi) {
                const int m = m0 + wm * 64 + mi * 32 + r31, pos = m & (SEQ - 1), b = m >> 13;
                unsigned char* rec = (unsigned char*)p.out + ((size_t)(b * 8 + h) * SEQ + pos) * 512;
#pragma unroll
                for (int blk = 0; blk < 2; ++blk)
#pragma unroll
                    for (int rg = 0; rg < 4; ++rg) {
                        const int j = blk * 32 + rg * 8 + hh * 4, n = h * 64 + j;
                        const f4 a04 = *(const f4*)(a0 + n);
                        f4 av;
#pragma unroll
                        for (int e = 0; e < 4; ++e) av[e] = sigm(a04[e] + acc[mi][blk][rg * 4 + e]);
                        *(f4*)(rec + (j >> 2) * 32 + 16) = av;
                    }
            }
        }
        __threadfence_block();
        __syncthreads();
#pragma unroll 2
        for (int it = 0; it < 16; ++it) {
            const int idx = it * NTHREADS + tid, pair = idx >> 4, jg = idx & 15;
            const int m = m0 + (pair >> 1), h = (n0 >> 6) + (pair & 1), pos = m & (SEQ - 1), b = m >> 13, n = h * 64 + 4 * jg;
            const half_t* prow = PR + (size_t)m * 1792; const half_t* pprev = prow - 1792; const bool hp = pos > 0;
            float rs[4], ks[4], vs[4];
            ld_shift4(prow + n, pprev + n, hp, mu + n, rs);
            ld_shift4(prow + 512 + n, pprev + 512 + n, hp, mu + 512 + n, ks);
            ld_shift4(prow + 1024 + n, pprev + 1024 + n, hp, mu + 1024 + n, vs);
            unsigned char* rec = (unsigned char*)p.out + ((size_t)(b * 8 + h) * SEQ + pos) * 512 + jg * 32;
            const f4 av = *(const f4*)(rec + 16);
            const f4 kk4 = *(const f4*)(kkw + n), ka4 = *(const f4*)(kaw + n), rk4 = *(const f4*)(rkw + n);
            float kkr[4], kp[4], ss = 0.f, rka = 0.f;
#pragma unroll
            for (int e = 0; e < 4; ++e) {
                kkr[e] = ks[e] * kk4[e]; ss += kkr[e] * kkr[e];
                kp[e] = ks[e] * (1.0f + (av[e] - 1.0f) * ka4[e]);
                rka += rs[e] * kp[e] * rk4[e];
            }
            ss = rowsum16(ss); rka = rowsum16(rka);
            const float inv = 1.0f / fmaxf(sqrtf(ss), 1e-12f);
            h8 w0v, w1v;
#pragma unroll
            for (int e = 0; e < 4; ++e) {
                const float kk = kkr[e] * inv;
                w0v[e] = (half_t)rs[e]; w0v[4 + e] = (half_t)kp[e];
                w1v[e] = (half_t)kk; w1v[4 + e] = (half_t)(kk * av[e]);
            }
            *(h8*)rec = w0v;
            *(h8*)(rec + 16) = w1v;
            *(h4*)((half_t*)(ws + OFF_VS) + (size_t)m * 512 + n) = pack4(vs[0], vs[1], vs[2], vs[3]);
            if (jg == 0) ((float*)(ws + OFF_RK))[(size_t)m * 8 + h] = rka;
        }
    }
}

struct ScanIn { f4 d; u32x4 h0, h1; h2 v; };
__device__ __forceinline__ void phase_scan(const Params& p) {
    const int lane = threadIdx.x & 63, wid = threadIdx.x >> 6;
    const int jg = lane & 15, sub = lane >> 4;
    if (wid >= 4) return;
    {
        const int xj = (int)blockIdx.x >> 3;
        const int bh = ((int)blockIdx.x & 7) + 8 * (xj >> 1), rgp = (xj & 1) * 4 + wid, b = bh >> 3, h = bh & 7, i = rgp * 8 + sub * 2;
        const f4* Dp = (const f4*)(p.ws + OFF_D) + (size_t)bh * SEQ * 16 + jg;
        const u32x4* Hp = (const u32x4*)p.out + (size_t)bh * SEQ * 32 + jg * 2;
        const half_t* Vp = (const half_t*)(p.ws + OFF_VS) + (size_t)b * SEQ * 512 + h * 64 + i;
        float* Yp = (float*)(p.ws + OFF_YRAW) + (size_t)b * SEQ * 512 + h * 64 + i;
        float a0 = 0.f, a1 = 0.f, a2 = 0.f, a3 = 0.f, b0 = 0.f, b1 = 0.f, b2 = 0.f, b3 = 0.f;
        ScanIn A[4], Bf[4], C[4];
#define SCAN_LOAD(buf, tb) { _Pragma("unroll") for (int q = 0; q < 4; ++q) { int tt = (tb) + q; tt = tt < SEQ ? tt : SEQ - 1; \
            buf[q].d = Dp[(size_t)tt * 16]; buf[q].h0 = Hp[(size_t)tt * 32]; buf[q].h1 = Hp[(size_t)tt * 32 + 1]; buf[q].v = *(const h2*)(Vp + (size_t)tt * 512); } }
#define SCAN_STEP(buf, tb) { float ya[4], yb[4]; _Pragma("unroll") for (int q = 0; q < 4; ++q) { \
            const h8 x0 = *(const h8*)&buf[q].h0, x1 = *(const h8*)&buf[q].h1; const f4 d = buf[q].d; \
            const float va = (float)buf[q].v[0], vb = (float)buf[q].v[1]; \
            const float k0 = (float)x1[0], k1 = (float)x1[1], k2 = (float)x1[2], k3 = (float)x1[3]; \
            const float g0 = (float)x1[4], g1 = (float)x1[5], g2 = (float)x1[6], g3 = (float)x1[7]; \
            const float r0 = (float)x0[0], r1 = (float)x0[1], r2 = (float)x0[2], r3 = (float)x0[3]; \
            const float p0 = (float)x0[4], p1 = (float)x0[5], p2 = (float)x0[6], p3 = (float)x0[7]; \
            float sa = (a0 * k0 + a1 * k1) + (a2 * k2 + a3 * k3), sb = (b0 * k0 + b1 * k1) + (b2 * k2 + b3 * k3); \
            sa += dppf<0x128>(sa); sb += dppf<0x128>(sb); sa += dppf<0x124>(sa); sb += dppf<0x124>(sb); \
            sa += dppf<0x122>(sa); sb += dppf<0x122>(sb); sa += dppf<0x121>(sa); sb += dppf<0x121>(sb); \
            a0 = (a0 * d[0] + va * p0) - sa * g0; a1 = (a1 * d[1] + va * p1) - sa * g1; a2 = (a2 * d[2] + va * p2) - sa * g2; a3 = (a3 * d[3] + va * p3) - sa * g3; \
            b0 = (b0 * d[0] + vb * p0) - sb * g0; b1 = (b1 * d[1] + vb * p1) - sb * g1; b2 = (b2 * d[2] + vb * p2) - sb * g2; b3 = (b3 * d[3] + vb * p3) - sb * g3; \
            float y1 = (a0 * r0 + a1 * r1) + (a2 * r2 + a3 * r3), y2 = (b0 * r0 + b1 * r1) + (b2 * r2 + b3 * r3); \
            y1 += dppf<0x128>(y1); y2 += dppf<0x128>(y2); y1 += dppf<0x124>(y1); y2 += dppf<0x124>(y2); \
            y1 += dppf<0x122>(y1); y2 += dppf<0x122>(y2); y1 += dppf<0x121>(y1); y2 += dppf<0x121>(y2); \
            ya[q] = y1; yb[q] = y2; } \
            if (jg == 0) { _Pragma("unroll") for (int q = 0; q < 4; ++q) if ((tb) + q < SEQ) *(float2*)(Yp + (size_t)((tb) + q) * 512) = make_float2(ya[q], yb[q]); } }
#define SCAN_LOADF(buf, tb) { const f4* dq_ = Dp + (size_t)(tb) * 16; const u32x4* hq_ = Hp + (size_t)(tb) * 32; const half_t* vq_ = Vp + (size_t)(tb) * 512; \
            _Pragma("unroll") for (int q = 0; q < 4; ++q) { buf[q].d = dq_[q * 16]; buf[q].h0 = hq_[q * 32]; buf[q].h1 = hq_[q * 32 + 1]; buf[q].v = *(const h2*)(vq_ + q * 512); } }
        SCAN_LOAD(A, 0); SCAN_LOAD(Bf, 4);
        int t0 = 0;
        for (; t0 + 24 <= SEQ; t0 += 12) {
            SCAN_LOADF(C, t0 + 8);
            SCAN_STEP(A, t0);
            SCAN_LOADF(A, t0 + 12);
            SCAN_STEP(Bf, t0 + 4);
            SCAN_LOADF(Bf, t0 + 16);
            SCAN_STEP(C, t0 + 8);
        }
        for (; t0 < SEQ; t0 += 12) {
            SCAN_LOAD(C, t0 + 8);
            SCAN_STEP(A, t0);
            SCAN_LOAD(A, t0 + 12);
            SCAN_STEP(Bf, t0 + 4);
            SCAN_LOAD(Bf, t0 + 16);
            SCAN_STEP(C, t0 + 8);
        }
#undef SCAN_LOADF
#undef SCAN_LOAD
#undef SCAN_STEP
    }
}

__device__ __forceinline__ unsigned fkey(float f) { const unsigned u = __float_as_uint(f); return (u & 0x80000000u) ? ~u : (u | 0x80000000u); }

#define HSTRIDE 2112
__device__ __forceinline__ void phase_indexer(const Params& p, unsigned char* lds, int blk0, int nblk) {
    unsigned* S = (unsigned*)lds;
    unsigned* hist = (unsigned*)(lds + 131072);
    int* misc = (int*)(lds + 131072 + 2 * HSTRIDE * 4);
    unsigned char* ws = p.ws;
    const half_t* QI = (const half_t*)(ws + OFF_QI);
    const half_t* KI = (const half_t*)(ws + OFF_KI);
    const float* WI = (const float*)(ws + OFF_WI);
    u16* SEL = (u16*)(ws + OFF_SEL);
    const int tid = threadIdx.x, lane = tid & 63, wid = tid >> 6, r31 = lane & 31, hh = lane >> 5;
    const int bx = (int)blockIdx.x - blk0;
    if (bx < 0 || bx >= nblk) return;
    const int hr = (r31 >> 2) & 1, ir = (r31 & 3) + 4 * (r31 >> 3), qr = 2 * hr + (ir >> 3), hdr = ir & 7;
    h8 afn[4]; f4 wn0, wn1, wn2, wn3;
#define IDX_FETCH(task_) { const int tk_ = (task_) < 8192 ? (task_) : bx; const int r0_ = (tk_ & 3) * SEQ + (tk_ >> 2) * 4; \
        const half_t* qp_ = QI + (size_t)(r0_ + qr) * 512 + hdr * 64 + 8 * hh; \
        _Pragma("unroll") for (int ks = 0; ks < 4; ++ks) afn[ks] = *(const h8*)(qp_ + ks * 16); \
        wn0 = *(const f4*)(WI + (size_t)(r0_ + 2 * hh) * 8); wn1 = *(const f4*)(WI + (size_t)(r0_ + 2 * hh) * 8 + 4); \
        wn2 = *(const f4*)(WI + (size_t)(r0_ + 2 * hh + 1) * 8); wn3 = *(const f4*)(WI + (size_t)(r0_ + 2 * hh + 1) * 8 + 4); }
    IDX_FETCH(bx)
    for (int task = bx; task < 8192; task += nblk) {
        const int b = task & 3, t0 = (task >> 2) * 4, row0 = b * SEQ + t0;
        u16* sel = SEL + (size_t)row0 * 256;
        h8 af[4];
#pragma unroll
        for (int ks = 0; ks < 4; ++ks) af[ks] = afn[ks];
        const f4 wa0 = wn0, wa1 = wn1, wb0 = wn2, wb1 = wn3;
        if (t0 < 256) {
            for (int idx = tid; idx < 1024; idx += NTHREADS) { const int q = idx >> 8, j = idx & 255; sel[idx] = (j <= t0 + q) ? (u16)j : (u16)0xFFFF; }
            IDX_FETCH(task + nblk)
            continue;
        }
        const int nc = (t0 + 4 + 31) >> 5, nn = nc * 32;
        const int ta = t0 + 2 * hh, tb = ta + 1;
        const half_t* kbase = KI + (size_t)b * SEQ * 64 + (size_t)lane * 8;
        {
            h8 bA[4][4], bB[4][4];
#define SC_LOAD(buf, cs) { _Pragma("unroll") for (int u = 0; u < 4; ++u) { int c = (cs) + 8 * u; c = c < nc ? c : nc - 1; const half_t* kp = kbase + (size_t)c * 2048; \
                _Pragma("unroll") for (int ks = 0; ks < 4; ++ks) buf[u][ks] = *(const h8*)(kp + ks * 512); } }
#define SC_PROC(buf, cs) { _Pragma("unroll") for (int u = 0; u < 4; ++u) { const int c = (cs) + 8 * u; if (c < nc) { const int s = c * 32 + r31; \
                f16v acc; _Pragma("unroll") for (int e = 0; e < 16; ++e) acc[e] = 0.f; \
                _Pragma("unroll") for (int ks = 0; ks < 4; ++ks) acc = __builtin_amdgcn_mfma_f32_32x32x16_f16(af[ks], buf[u][ks], acc, 0, 0, 0); \
                float sa0 = 0.f, sa1 = 0.f, sb0 = 0.f, sb1 = 0.f; \
                _Pragma("unroll") for (int e = 0; e < 4; ++e) { sa0 += wa0[e] * fmaxf(acc[e], 0.f); sa1 += wa1[e] * fmaxf(acc[4 + e], 0.f); sb0 += wb0[e] * fmaxf(acc[8 + e], 0.f); sb1 += wb1[e] * fmaxf(acc[12 + e], 0.f); } \
                S[(2 * hh) * 8192 + s] = (s <= ta) ? fkey(sa0 + sa1) : 0u; S[(2 * hh + 1) * 8192 + s] = (s <= tb) ? fkey(sb0 + sb1) : 0u; } } }
            SC_LOAD(bA, wid)
            for (int c0 = wid; c0 < nc; c0 += 64) {
                SC_LOAD(bB, c0 + 32)
                SC_PROC(bA, c0)
                SC_LOAD(bA, c0 + 64)
                SC_PROC(bB, c0 + 32)
            }
#undef SC_LOAD
#undef SC_PROC
        }
        IDX_FETCH(task + nblk)
        __syncthreads();
        unsigned T0 = 0, T1 = 0, T2 = 0, T3 = 0, pmask = 0; int k0 = 256, k1 = 256, k2 = 256, k3 = 256;
#pragma unroll 1
        for (int pass = 0; pass < 3; ++pass) {
            const int shift = pass == 0 ? 21 : (pass == 1 ? 10 : 0);
            const unsigned dmask = pass == 2 ? 1023u : 2047u;
            for (int i = tid; i < 2 * HSTRIDE; i += NTHREADS) hist[i] = 0u;
            __syncthreads();
            for (int s = tid; s < nn; s += NTHREADS) {
                const unsigned key0 = S[s], key1 = S[8192 + s], key2 = S[16384 + s], key3 = S[24576 + s];
                if ((key0 & pmask) == T0) { const unsigned bin = (key0 >> shift) & dmask; atomicAdd(&hist[bin + (bin >> 5)], 1u); }
                if ((key1 & pmask) == T1) { const unsigned bin = (key1 >> shift) & dmask; atomicAdd(&hist[bin + (bin >> 5)], 65536u); }
                if ((key2 & pmask) == T2) { const unsigned bin = (key2 >> shift) & dmask; atomicAdd(&hist[HSTRIDE + bin + (bin >> 5)], 1u); }
                if ((key3 & pmask) == T3) { const unsigned bin = (key3 >> shift) & dmask; atomicAdd(&hist[HSTRIDE + bin + (bin >> 5)], 65536u); }
            }
            __syncthreads();
            if (wid < 4) {
                const unsigned* hb = hist + (wid >> 1) * HSTRIDE + 33 * lane;
                const int sh = (wid & 1) * 16;
                const int kl = wid == 0 ? k0 : (wid == 1 ? k1 : (wid == 2 ? k2 : k3));
                int tot = 0;
#pragma unroll 8
                for (int i = 0; i < 32; ++i) tot += (int)((hb[i] >> sh) & 0xFFFFu);
                int v = tot;
#pragma unroll
                for (int off = 1; off < 64; off <<= 1) { const int o = __shfl_down(v, off); if (lane + off < 64) v += o; }
                const int sufx = v - tot;
                const unsigned long long fb = __ballot(sufx < kl && kl <= sufx + tot);
                const int L = (int)__builtin_ctzll(fb);
                const int kk = kl - __builtin_amdgcn_readlane(sufx, L);
                const unsigned cw = lane < 32 ? hist[(wid >> 1) * HSTRIDE + 33 * L + lane] : 0u;
                const int c = (int)((cw >> sh) & 0xFFFFu);
                int ci = c;
#pragma unroll
                for (int off = 1; off < 64; off <<= 1) { const int o = __shfl_down(ci, off); if (lane + off < 64) ci += o; }
                const int cx = ci - c;
                if (cx < kk && kk <= cx + c) { misc[2 * wid] = 32 * L + lane; misc[2 * wid + 1] = kk - cx; misc[8 + wid] = (c == kk - cx) ? 1 : 0; }
            }
            __syncthreads();
            T0 |= (unsigned)misc[0] << shift; k0 = misc[1];
            T1 |= (unsigned)misc[2] << shift; k1 = misc[3];
            T2 |= (unsigned)misc[4] << shift; k2 = misc[5];
            T3 |= (unsigned)misc[6] << shift; k3 = misc[7];
            pmask |= dmask << shift;
            if (pass == 1 && (misc[8] & misc[9] & misc[10] & misc[11])) break;
        }
        const int cl = (((nn + 7) >> 3) + 63) & ~63;
        const int slo = wid * cl, shi = min(nn, slo + cl);
        int* cnt = misc + 32;
        {
            int cg0 = 0, cg1 = 0, cg2 = 0, cg3 = 0, ce0 = 0, ce1 = 0, ce2 = 0, ce3 = 0;
            for (int sb0 = slo; sb0 < shi; sb0 += 64) {
                const int s = sb0 + lane; const bool in = s < shi;
                const unsigned x0 = in ? (S[s] & pmask) : 0u, x1 = in ? (S[8192 + s] & pmask) : 0u, x2 = in ? (S[16384 + s] & pmask) : 0u, x3 = in ? (S[24576 + s] & pmask) : 0u;
                cg0 += __popcll(__ballot(x0 > T0)); ce0 += __popcll(__ballot(x0 == T0));
                cg1 += __popcll(__ballot(x1 > T1)); ce1 += __popcll(__ballot(x1 == T1));
                cg2 += __popcll(__ballot(x2 > T2)); ce2 += __popcll(__ballot(x2 == T2));
                cg3 += __popcll(__ballot(x3 > T3)); ce3 += __popcll(__ballot(x3 == T3));
            }
            if (lane == 0) {
                cnt[(0 * 8 + wid) * 2] = cg0; cnt[(0 * 8 + wid) * 2 + 1] = ce0; cnt[(1 * 8 + wid) * 2] = cg1; cnt[(1 * 8 + wid) * 2 + 1] = ce1;
                cnt[(2 * 8 + wid) * 2] = cg2; cnt[(2 * 8 + wid) * 2 + 1] = ce2; cnt[(3 * 8 + wid) * 2] = cg3; cnt[(3 * 8 + wid) * 2 + 1] = ce3;
            }
        }
        __syncthreads();
        {
            const unsigned long long ltmask = (1ull << lane) - 1ull;
            int og0 = 0, og1 = 0, og2 = 0, og3 = 0, oe0 = 0, oe1 = 0, oe2 = 0, oe3 = 0;
#pragma unroll
            for (int w = 0; w < 8; ++w) if (w < wid) {
                og0 += cnt[(0 * 8 + w) * 2]; oe0 += cnt[(0 * 8 + w) * 2 + 1]; og1 += cnt[(1 * 8 + w) * 2]; oe1 += cnt[(1 * 8 + w) * 2 + 1];
                og2 += cnt[(2 * 8 + w) * 2]; oe2 += cnt[(2 * 8 + w) * 2 + 1]; og3 += cnt[(3 * 8 + w) * 2]; oe3 += cnt[(3 * 8 + w) * 2 + 1];
            }
#define WR1(q, xq, Tq, kq, og, oe) { const bool gt = xq > Tq, eq = xq == Tq; const unsigned long long bg = __ballot(gt), be = __ballot(eq); u16* so = sel + q * 256; \
                if (gt) { const int pos = og + __popcll(bg & ltmask); if (pos < 256) so[pos] = (u16)s; } \
                if (eq) { const int rk = oe + __popcll(be & ltmask); if (rk < kq) so[(256 - kq) + rk] = (u16)s; } \
                og += __popcll(bg); oe += __popcll(be); }
            for (int sb0 = slo; sb0 < shi; sb0 += 64) {
                const int s = sb0 + lane; const bool in = s < shi;
                const unsigned x0 = in ? (S[s] & pmask) : 0u, x1 = in ? (S[8192 + s] & pmask) : 0u, x2 = in ? (S[16384 + s] & pmask) : 0u, x3 = in ? (S[24576 + s] & pmask) : 0u;
                WR1(0, x0, T0, k0, og0, oe0) WR1(1, x1, T1, k1, og1, oe1) WR1(2, x2, T2, k2, og2, oe2) WR1(3, x3, T3, k3, og3, oe3)
            }
#undef WR1
        }
        __syncthreads();
    }
}

__device__ __forceinline__ void phase_post(const Params& p) {
    unsigned char* ws = p.ws;
    const float* YR = (const float*)(ws + OFF_YRAW);
    const half_t* VS = (const half_t*)(ws + OFF_VS);
    const half_t* G = (const half_t*)(ws + OFF_G);
    const float* RK = (const float*)(ws + OFF_RK);
    half_t* YA = (half_t*)(ws + OFF_D);
    const float* lg = p.in[I_LNG]; const float* lb = p.in[I_LNB];
    for (int i = blockIdx.x * NTHREADS + threadIdx.x; i < NTOK * 128; i += gridDim.x * NTHREADS) {
        const int m = i >> 7, n = (i & 127) * 4, h = n >> 6;
        const f4 y = *(const f4*)(YR + (size_t)m * 512 + n);
        const float mean = rowsum16(y[0] + y[1] + y[2] + y[3]) * (1.0f / 64.0f);
        const float d0 = y[0] - mean, d1 = y[1] - mean, d2 = y[2] - mean, d3 = y[3] - mean;
        const float var = rowsum16(d0 * d0 + d1 * d1 + d2 * d2 + d3 * d3) * (1.0f / 64.0f);
        const float rs = rsqrtf(var + 64e-5f);
        const f4 g4 = *(const f4*)(lg + n), b4 = *(const f4*)(lb + n);
        const h4 v4 = *(const h4*)(VS + (size_t)m * 512 + n), gg = *(const h4*)(G + (size_t)m * 512 + n);
        const float rk = RK[(size_t)m * 8 + h];
        const float o0 = (d0 * rs * g4[0] + b4[0] + rk * (float)v4[0]) * (float)gg[0];
        const float o1 = (d1 * rs * g4[1] + b4[1] + rk * (float)v4[1]) * (float)gg[1];
        const float o2 = (d2 * rs * g4[2] + b4[2] + rk * (float)v4[2]) * (float)gg[2];
        const float o3 = (d3 * rs * g4[3] + b4[3] + rk * (float)v4[3]) * (float)gg[3];
        *(h4*)(YA + (size_t)m * 512 + n) = pack4(o0, o1, o2, o3);
    }
}

__device__ __forceinline__ float dot8h(const h8 a, const h8 b) {
#if __has_builtin(__builtin_amdgcn_fdot2)
    float d = 0.f;
    d = __builtin_amdgcn_fdot2((h2){a[0], a[1]}, (h2){b[0], b[1]}, d, false);
    d = __builtin_amdgcn_fdot2((h2){a[2], a[3]}, (h2){b[2], b[3]}, d, false);
    d = __builtin_amdgcn_fdot2((h2){a[4], a[5]}, (h2){b[4], b[5]}, d, false);
    d = __builtin_amdgcn_fdot2((h2){a[6], a[7]}, (h2){b[6], b[7]}, d, false);
    return d;
#else
    float d = 0.f;
#pragma unroll
    for (int e = 0; e < 8; ++e) d += (float)a[e] * (float)b[e];
    return d;
#endif
}

__device__ __forceinline__ void phase_attn(const Params& p, unsigned char* lds, int blk0, int nblk) {
    unsigned char* ws = p.ws;
    const half_t* Q = (const half_t*)(ws + OFF_Q);
    const half_t* KH = (const half_t*)(ws + OFF_KH);
    const half_t* VH = (const half_t*)(ws + OFF_VH);
    const u16* SEL = (const u16*)(ws + OFF_SEL);
    half_t* YB = (half_t*)(ws + OFF_YB);
    const int tid = threadIdx.x, lane = tid & 63, wid = tid >> 6, g = lane >> 3, dq = lane & 7;
    int* offs = (int*)(lds + wid * 1024);
    const int bx = (int)blockIdx.x - blk0;
    if (bx < 0 || bx >= nblk) return;
    const int cls = blockIdx.x & 7;
    const int first = (cls - (blk0 & 7) + 8) & 7;
    const int ncls = (nblk - first + 7) >> 3;
    const int ib = (bx - first) >> 3;
    const int wv = ib * 8 + wid, nwv = ncls * 8;
    for (int bhi = 0; bhi < 4; ++bhi) {
        const int bh = cls + 8 * bhi, b = bh >> 3, h = bh & 7;
        const unsigned char* Kb = (const unsigned char*)(KH + (size_t)bh * SEQ * 64);
        const unsigned char* Vb = (const unsigned char*)(VH + (size_t)bh * SEQ * 64);
        int t = wv;
        unsigned sraw[4]; h8 qn;
#pragma unroll
        for (int e = 0; e < 8; ++e) qn[e] = (half_t)0.f;
#pragma unroll
        for (int i = 0; i < 4; ++i) sraw[i] = 0;
        if (t < SEQ) {
            const size_t row = (size_t)b * SEQ + t;
#pragma unroll
            for (int i = 0; i < 4; ++i) sraw[i] = SEL[row * 256 + lane + 64 * i];
            qn = *(const h8*)(Q + row * 512 + h * 64 + dq * 8);
        }
        for (; t < SEQ; t += nwv) {
            const size_t row = (size_t)b * SEQ + t;
#pragma unroll
            for (int i = 0; i < 4; ++i) { const unsigned idx = sraw[i] > 8191u ? 0u : sraw[i]; offs[lane + 64 * i] = (int)idx * 128; }
            const h8 q8 = qn;
            const int tn = t + nwv;
            if (tn < SEQ) {
                const size_t rown = (size_t)b * SEQ + tn;
#pragma unroll
                for (int i = 0; i < 4; ++i) sraw[i] = SEL[rown * 256 + lane + 64 * i];
                qn = *(const h8*)(Q + rown * 512 + h * 64 + dq * 8);
            }
            __builtin_amdgcn_wave_barrier();
            asm volatile("s_waitcnt lgkmcnt(0)" ::: "memory");
            unsigned of[32];
#pragma unroll
            for (int it = 0; it < 32; ++it) of[it] = (unsigned)offs[it * 8 + g] + (unsigned)dq * 16u;
            h8 kr[32];
#pragma unroll
            for (int it = 0; it < 32; ++it) kr[it] = *(const h8*)(Kb + of[it]);
            float lg[32];
            float mx = -INFINITY;
#pragma unroll
            for (int it = 0; it < 32; ++it) {
                float d = sum8(dot8h(q8, kr[it]));
                d = (it * 8 + g <= t) ? d : -INFINITY;
                lg[it] = d; mx = fmaxf(mx, d);
            }
            asm volatile("" : "+v"(mx) :: "memory");
            h8 vr[32];
#pragma unroll
            for (int it = 0; it < 32; ++it) vr[it] = *(const h8*)(Vb + of[it]);
            mx = fmaxf(mx, __shfl_xor(mx, 8)); mx = fmaxf(mx, __shfl_xor(mx, 16)); mx = fmaxf(mx, __shfl_xor(mx, 32));
            float sum = 0.f;
#pragma unroll
            for (int it = 0; it < 32; ++it) { lg[it] = __expf(lg[it] - mx); sum += lg[it]; }
            sum += __shfl_xor(sum, 8); sum += __shfl_xor(sum, 16); sum += __shfl_xor(sum, 32);
            float o[8];
#pragma unroll
            for (int e = 0; e < 8; ++e) o[e] = 0.f;
#pragma unroll
            for (int it = 0; it < 32; ++it)
#pragma unroll
                for (int e = 0; e < 8; ++e) o[e] += lg[it] * (float)vr[it][e];
            const float inv = 1.0f / sum;
#pragma unroll
            for (int e = 0; e < 8; ++e) { o[e] += __shfl_xor(o[e], 8); o[e] += __shfl_xor(o[e], 16); o[e] += __shfl_xor(o[e], 32); }
            if (g == 0) {
                h8 w;
#pragma unroll
                for (int e = 0; e < 8; ++e) w[e] = (half_t)(o[e] * inv);
                *(h8*)(YB + row * 512 + h * 64 + dq * 8) = w;
            }
            __builtin_amdgcn_wave_barrier();
        }
    }
}

__device__ __forceinline__ void phase_merge(const Params& p, unsigned char* lds) {
    unsigned char* ws = p.ws;
    const half_t* U = (const half_t*)(ws + OFF_U16);
    const half_t* WG = (const half_t*)(ws + OFF_WG);
    const half_t* YA = (const half_t*)(ws + OFF_D);
    const half_t* YB = (const half_t*)(ws + OFF_YB);
    half_t* MG = (half_t*)(ws + OFF_Q);
    const int tid = threadIdx.x, lane = tid & 63, wid = tid >> 6, wm = wid >> 1, wn = wid & 1, r31 = lane & 31, hh = lane >> 5;
    XCD_TILE_LOOP(8) {
        int mt, nt; xcd_tile(L_, 8, mt, nt); const int m0 = mt * 256, n0 = nt * 128;
        unsigned sg[2][2][8], mg[2][2][8];
        {
            f16v acc[2][2];
            gemm_main<2>(acc, U, 1024, WG, 1024, 1024, m0, n0, lds);
#pragma unroll
            for (int mi = 0; mi < 2; ++mi)
#pragma unroll
                for (int nj = 0; nj < 2; ++nj) {
#pragma unroll
                    for (int e = 0; e < 8; ++e) { h2 w; w[0] = (half_t)sigm(acc[mi][nj][2 * e]); w[1] = (half_t)sigm(acc[mi][nj][2 * e + 1]); sg[mi][nj][e] = __builtin_bit_cast(unsigned, w); }
                    asm volatile("" : "+v"(sg[mi][nj][0]), "+v"(sg[mi][nj][1]), "+v"(sg[mi][nj][2]), "+v"(sg[mi][nj][3]), "+v"(sg[mi][nj][4]), "+v"(sg[mi][nj][5]), "+v"(sg[mi][nj][6]), "+v"(sg[mi][nj][7]));
                }
        }
        {
            f16v acc[2][2];
            gemm_main<2>(acc, YA, 512, (const half_t*)(ws + OFF_WOR), 512, 512, m0, n0, lds);
#pragma unroll
            for (int mi = 0; mi < 2; ++mi)
#pragma unroll
                for (int nj = 0; nj < 2; ++nj) {
#pragma unroll
                    for (int e = 0; e < 8; ++e) { const h2 s2 = __builtin_bit_cast(h2, sg[mi][nj][e]); h2 w; w[0] = (half_t)(acc[mi][nj][2 * e] * (float)s2[0]); w[1] = (half_t)(acc[mi][nj][2 * e + 1] * (float)s2[1]); mg[mi][nj][e] = __builtin_bit_cast(unsigned, w); }
                    asm volatile("" : "+v"(mg[mi][nj][0]), "+v"(mg[mi][nj][1]), "+v"(mg[mi][nj][2]), "+v"(mg[mi][nj][3]), "+v"(mg[mi][nj][4]), "+v"(mg[mi][nj][5]), "+v"(mg[mi][nj][6]), "+v"(mg[mi][nj][7]));
                }
        }
        {
            f16v acc[2][2];
            gemm_main<2>(acc, U, 1024, WG + (size_t)1024 * 1024, 1024, 1024, m0, n0, lds);
#pragma unroll
            for (int mi = 0; mi < 2; ++mi)
#pragma unroll
                for (int nj = 0; nj < 2; ++nj) {
#pragma unroll
                    for (int e = 0; e < 8; ++e) { h2 w; w[0] = (half_t)sigm(acc[mi][nj][2 * e]); w[1] = (half_t)sigm(acc[mi][nj][2 * e + 1]); sg[mi][nj][e] = __builtin_bit_cast(unsigned, w); }
                    asm volatile("" : "+v"(sg[mi][nj][0]), "+v"(sg[mi][nj][1]), "+v"(sg[mi][nj][2]), "+v"(sg[mi][nj][3]), "+v"(sg[mi][nj][4]), "+v"(sg[mi][nj][5]), "+v"(sg[mi][nj][6]), "+v"(sg[mi][nj][7]));
                }
        }
        {
            f16v acc[2][2];
            gemm_main<2>(acc, YB, 512, (const half_t*)(ws + OFF_WOA), 512, 512, m0, n0, lds);
#pragma unroll
            for (int mi = 0; mi < 2; ++mi) {
                const int m = m0 + wm * 64 + mi * 32 + r31;
#pragma unroll
                for (int nj = 0; nj < 2; ++nj)
#pragma unroll
                    for (int rg = 0; rg < 4; ++rg) {
                        const int n = n0 + wn * 64 + nj * 32 + rg * 8 + hh * 4;
                        float o[4];
#pragma unroll
                        for (int e = 0; e < 4; ++e) { const int r = rg * 4 + e; const h2 m2 = __builtin_bit_cast(h2, mg[mi][nj][r >> 1]), s2 = __builtin_bit_cast(h2, sg[mi][nj][r >> 1]); o[e] = (float)m2[r & 1] + acc[mi][nj][r] * (float)s2[r & 1]; }
                        *(h4*)(MG + (size_t)m * 1024 + n) = pack4(o[0], o[1], o[2], o[3]);
                    }
            }
        }
    }
}

__device__ __forceinline__ void phase_outproj(const Params& p, unsigned char* lds) {
    const half_t* MG = (const half_t*)(p.ws + OFF_Q);
    const half_t* W = (const half_t*)(p.ws + OFF_WOUT);
    const float* x = p.in[I_X];
    const int tid = threadIdx.x, lane = tid & 63, wid = tid >> 6, wm = wid >> 1, wn = wid & 1, r31 = lane & 31, hh = lane >> 5;
    XCD_TILE_LOOP(4) {
        int mt, nt; xcd_tile(L_, 4, mt, nt); const int m0 = mt * 256, n0 = nt * 256;
        f16v acc[2][4];
        gemm_main<4>(acc, MG, 1024, W, 1024, 1024, m0, n0, lds);
#pragma unroll
        for (int mi = 0; mi < 2; ++mi) {
            const int m = m0 + wm * 64 + mi * 32 + r31;
#pragma unroll
            for (int nj = 0; nj < 4; ++nj)
#pragma unroll
                for (int rg = 0; rg < 4; ++rg) {
                    const size_t o = (size_t)m * 1024 + n0 + wn * 128 + nj * 32 + rg * 8 + hh * 4;
                    f4 v = *(const f4*)(x + o);
                    v[0] += acc[mi][nj][rg * 4]; v[1] += acc[mi][nj][rg * 4 + 1]; v[2] += acc[mi][nj][rg * 4 + 2]; v[3] += acc[mi][nj][rg * 4 + 3];
                    *(f4*)(p.out + o) = v;
                }
        }
    }
}

__device__ __forceinline__ void phase_ffn1(const Params& p, unsigned char* lds) {
    const half_t* U = (const half_t*)(p.ws + OFF_U16);
    const half_t* W = (const half_t*)(p.ws + OFF_WF1);
    half_t* ACT = (half_t*)(p.ws + OFF_PR);
    const int tid = threadIdx.x, lane = tid & 63, wid = tid >> 6, wm = wid >> 1, wn = wid & 1, r31 = lane & 31, hh = lane >> 5;
    XCD_TILE_LOOP(22) {
        int mt, nt; xcd_tile(L_, 22, mt, nt); const int m0 = mt * 256, n0 = nt * 256;
        f16v acc[2][4];
        gemm_main<4>(acc, U, 1024, W, 1024, 1024, m0, n0, lds);
#pragma unroll
        for (int mi = 0; mi < 2; ++mi) {
            const int m = m0 + wm * 64 + mi * 32 + r31;
#pragma unroll
            for (int pr = 0; pr < 2; ++pr)
#pragma unroll
                for (int rg = 0; rg < 4; ++rg) {
                    const int c = ((n0 + wn * 128) >> 1) + pr * 32 + rg * 8 + hh * 4;
                    float o[4];
#pragma unroll
                    for (int e = 0; e < 4; ++e) { const float gt = acc[mi][2 * pr][rg * 4 + e], up = acc[mi][2 * pr + 1][rg * 4 + e]; o[e] = gt * sigm(gt) * up; }
                    *(h4*)(ACT + (size_t)m * 2816 + c) = pack4(o[0], o[1], o[2], o[3]);
                }
        }
    }
}

__device__ __forceinline__ void phase_ffn2(const Params& p, unsigned char* lds) {
    const half_t* ACT = (const half_t*)(p.ws + OFF_PR);
    const half_t* W = (const half_t*)(p.ws + OFF_WF2);
    const int tid = threadIdx.x, lane = tid & 63, wid = tid >> 6, wm = wid >> 1, wn = wid & 1, r31 = lane & 31, hh = lane >> 5;
    XCD_TILE_LOOP(4) {
        int mt, nt; xcd_tile(L_, 4, mt, nt); const int m0 = mt * 256, n0 = nt * 256;
        f16v acc[2][4];
        gemm_main<4>(acc, ACT, 2816, W, 2816, 2816, m0, n0, lds);
#pragma unroll
        for (int mi = 0; mi < 2; ++mi) {
            const int m = m0 + wm * 64 + mi * 32 + r31;
#pragma unroll
            for (int nj = 0; nj < 4; ++nj)
#pragma unroll
                for (int rg = 0; rg < 4; ++rg) {
                    const size_t o = (size_t)m * 1024 + n0 + wn * 128 + nj * 32 + rg * 8 + hh * 4;
                    f4 v = *(const f4*)(p.out + o);
                    v[0] += acc[mi][nj][rg * 4]; v[1] += acc[mi][nj][rg * 4 + 1]; v[2] += acc[mi][nj][rg * 4 + 2]; v[3] += acc[mi][nj][rg * 4 + 3];
                    *(f4*)(p.out + o) = v;
                }
        }
    }
}

__device__ __forceinline__ void phase_final(const Params& p) {
    const int lane = threadIdx.x & 63, wid = threadIdx.x >> 6;
    const float* g = p.in[I_NFG];
    for (int row = blockIdx.x * 8 + wid; row < NTOK; row += gridDim.x * 8) {
        f4* xr = (f4*)(p.out + (size_t)row * 1024);
        f4 v[4]; float ss = 0.f;
#pragma unroll
        for (int i = 0; i < 4; ++i) { v[i] = xr[lane + 64 * i]; ss += v[i][0] * v[i][0] + v[i][1] * v[i][1] + v[i][2] * v[i][2] + v[i][3] * v[i][3]; }
        ss = wave_sum(ss);
        const float rs = rsqrtf(ss * (1.0f / 1024.0f) + 1e-6f);
#pragma unroll
        for (int i = 0; i < 4; ++i) {
            const f4 gg = ((const f4*)g)[lane + 64 * i];
            f4 w; w[0] = v[i][0] * rs * gg[0]; w[1] = v[i][1] * rs * gg[1]; w[2] = v[i][2] * rs * gg[2]; w[3] = v[i][3] * rs * gg[3];
            xr[lane + 64 * i] = w;
        }
    }
}

#define NPHASES 13
__global__ void __launch_bounds__(NTHREADS) mk_fwd(Params p, int ph_lo, int ph_hi, int coop) {
    extern __shared__ __attribute__((aligned(16))) unsigned char lds[];
    cg::grid_group grid = cg::this_grid();
#define PHASE(id, body) if (ph_lo <= id && id < ph_hi) { int reps_ = (id == PROBE_DUP) ? 2 : 1; if (id == PROBE_DUP) asm volatile("" : "+s"(reps_)); _Pragma("nounroll") for (int rep_ = 0; rep_ < reps_; ++rep_) { body; if (rep_ + 1 < reps_) grid.sync(); } if (coop && id + 1 < ph_hi) grid.sync(); }
    PHASE(0, phase_convert(p, lds))
    PHASE(1, phase_inproj(p, lds))
    PHASE(2, phase_prep(p))
    PHASE(3, phase_lora(p, lds))
    PHASE(4, { if (blockIdx.x < 64) phase_scan(p); else phase_indexer(p, lds, 64, (int)gridDim.x - 64); })
    PHASE(6, { phase_post(p); phase_attn(p, lds, 0, gridDim.x); })
    PHASE(7, phase_merge(p, lds))
    PHASE(8, phase_outproj(p, lds))
    PHASE(9, rmsnorm_rows_f16(p.out, p.in[I_N2G], (half_t*)(p.ws + OFF_U16)))
    PHASE(10, phase_ffn1(p, lds))
    PHASE(11, phase_ffn2(p, lds))
    PHASE(12, phase_final(p))
#undef PHASE
}

#ifndef MK_COOP
#define MK_COOP 1
#endif

extern "C" void kernel_launch(void* const* d_in, const int* in_sizes, int n_in, void* d_out, int out_size, void* d_ws, size_t ws_size, hipStream_t stream) {
    static int grid = 0;
    if (grid == 0) {
        if (n_in != 21 || out_size != NTOK * 1024 || ws_size < WS_END) { fprintf(stderr, "kernel_launch: unexpected shapes (n_in %d out %d ws %zu, need %zu)\n", n_in, out_size, ws_size, (size_t)WS_END); grid = -1; return; }
        int dev = 0, cus = 0, per_cu = 0;
        (void)hipGetDevice(&dev);
        (void)hipDeviceGetAttribute(&cus, hipDeviceAttributeMultiprocessorCount, dev);
        if (hipFuncSetAttribute((const void*)mk_fwd, hipFuncAttributeMaxDynamicSharedMemorySize, LDS_BYTES) != hipSuccess) { fprintf(stderr, "kernel_launch: hipFuncSetAttribute failed\n"); grid = -1; return; }
        if (hipOccupancyMaxActiveBlocksPerMultiprocessor(&per_cu, (const void*)mk_fwd, NTHREADS, LDS_BYTES) != hipSuccess || per_cu < 1) { fprintf(stderr, "kernel_launch: occupancy query gave %d\n", per_cu); per_cu = 1; }
        (void)hipGetLastError();
        grid = cus * per_cu;
        grid &= ~7;
        if (grid < 72) grid = 72;
    }
    if (grid < 0) return;
    Params p;
    memset(&p, 0, sizeof(p));
    for (int i = 0; i < 21; ++i) p.in[i] = (const float*)d_in[i];
    p.out = (float*)d_out; p.ws = (unsigned char*)d_ws;
    for (int j = 0; j < 32; ++j) p.invf[j] = pow(10000.0, -(double)j / 32.0);
#if MK_COOP
    int lo = 0, hi = NPHASES, coop = 1;
    void* args[] = {&p, &lo, &hi, &coop};
    hipError_t e = hipLaunchCooperativeKernel((const void*)mk_fwd, dim3(grid), dim3(NTHREADS), args, LDS_BYTES, stream);
    if (e != hipSuccess) fprintf(stderr, "cooperative launch failed: %s (grid %d)\n", hipGetErrorString(e), grid);
#else
    for (int ph = 0; ph < NPHASES; ++ph)
        hipLaunchKernelGGL(mk_fwd, dim3(grid), dim3(NTHREADS), LDS_BYTES, stream, p, ph, ph + 1, 0);
#endif
}
```
